# Optimizing an MI355X kernel written in HIP

```python
import math
import jax
import jax.numpy as jnp
from jax import lax
import numpy as np


D_MODEL = 1024
BATCH = 8
SEQ = 2048
DEPTH = 4
DEC_BATCH = 16
DEC_SEQ = 4096
PAST_LEN = 128

PLE_DIM = 256
HG_WIDTH = D_MODEL // 2
HG_HEADS = 4
HG_DK = HG_WIDTH // HG_HEADS
HG_DV = HG_WIDTH // HG_HEADS
HG_CHUNK = 64
LB_FLOOR = 1e-30
DA_WIDTH = D_MODEL // 2
DA_HEADS = 4
DA_DV = DA_WIDTH // DA_HEADS
DA_DH = DA_DV // 2
Q_BLOCK = 128
D_FF = 2816
CONV_W = 3
ROPE_THETA = 10000.0
EPS = 1e-6
IN_COLS = 5 * HG_WIDTH + 3 * DA_WIDTH + 2 * D_MODEL

kernel_name = "hybrid_hgrn2_diffattn_encoder"


def rms_norm(x, w):
    xf = x.astype(jnp.float32)
    y = xf * lax.rsqrt(jnp.mean(xf * xf, axis=-1, keepdims=True) + EPS)
    return (y * w.astype(jnp.float32)).astype(x.dtype)


def rms_unit(x):
    xf = x.astype(jnp.float32)
    return (xf * lax.rsqrt(jnp.mean(xf * xf, axis=-1, keepdims=True) + EPS)).astype(x.dtype)


def rope_tables(L, dtype):
    inv = 1.0 / (ROPE_THETA ** (jnp.arange(0, DA_DH, 2, dtype=jnp.float32) / DA_DH))
    ang = jnp.arange(L, dtype=jnp.float32)[:, None] * inv[None, :]
    ang = jnp.concatenate([ang, ang], axis=-1)
    return jnp.cos(ang).astype(dtype), jnp.sin(ang).astype(dtype)


def apply_rope(x, cos, sin):
    x1, x2 = jnp.split(x, 2, axis=-1)
    return x * cos + jnp.concatenate([-x2, x1], axis=-1) * sin


def gla_chunk_scan(q, k, v, log_f):
    B, H, L, dk = q.shape
    dv = v.shape[-1]
    n = L // HG_CHUNK

    def to_chunks(a):
        return jnp.moveaxis(a.reshape(B, H, n, HG_CHUNK, a.shape[-1]), 2, 0)

    causal = jnp.tril(jnp.ones((HG_CHUNK, HG_CHUNK), dtype=bool))[:, :, None]

    def step(S, inp):
        qc, kc, vc, gc = inp
        b = jnp.cumsum(gc, axis=-2)
        diff = b[..., :, None, :] - b[..., None, :, :]
        decay = jnp.where(causal, jnp.exp(jnp.where(causal, diff, 0.0)), 0.0)
        A = jnp.einsum('bhtk,bhsk,bhtsk->bhts', qc, kc, decay)
        o = (jnp.einsum('bhts,bhsv->bhtv', A, vc)
             + jnp.einsum('bhtk,bhkv->bhtv', qc * jnp.exp(b), S))
        b_last = b[..., -1:, :]
        S = (jnp.exp(b_last[..., 0, :])[..., None] * S
             + jnp.einsum('bhsk,bhsv->bhkv', kc * jnp.exp(b_last - b), vc))
        return S, o

    S0 = jnp.zeros((B, H, dk, dv), jnp.float32)
    _, o = lax.scan(step, S0, (to_chunks(q), to_chunks(k), to_chunks(v), to_chunks(log_f)))
    return jnp.moveaxis(o, 0, 2).reshape(B, H, L, dv)


def hgrn2_mixer(q_raw, f_fw_raw, f_bw_raw, i_raw, g_raw, lb, gnorm_w):
    B, L, _ = q_raw.shape
    dt = q_raw.dtype

    def heads(a):
        return a.reshape(B, L, HG_HEADS, -1).transpose(0, 2, 1, 3)

    q = heads(jax.nn.silu(q_raw.astype(jnp.float32))) * (HG_DK ** -0.5)
    v = heads(i_raw.astype(jnp.float32))

    def gates(f_raw, lb_d):
        z = f_raw.astype(jnp.float32)
        log_f = jnp.logaddexp(jnp.log(jnp.maximum(lb_d, LB_FLOOR)),
                              jnp.log1p(-lb_d) + jax.nn.log_sigmoid(z))
        k = (1.0 - lb_d) * jax.nn.sigmoid(-z)
        return heads(k), heads(log_f)

    k_fw, g_fw = gates(f_fw_raw, lb[0])
    k_bw, g_bw = gates(f_bw_raw, lb[1])
    o_fw = gla_chunk_scan(q, k_fw, v, g_fw)
    o_bw = jnp.flip(gla_chunk_scan(jnp.flip(q, 2), jnp.flip(k_bw, 2), jnp.flip(v, 2), jnp.flip(g_bw, 2)), 2)
    o = (o_fw + o_bw).transpose(0, 2, 1, 3)
    gate = jax.nn.silu(g_raw.astype(jnp.float32).reshape(B, L, HG_HEADS, HG_DV))
    o = rms_norm(o, gnorm_w) * gate
    return o.reshape(B, L, HG_WIDTH).astype(dt)


def diff_attention(q_raw, k_raw, v_raw, lam_params, lambda_init, subln_w, cos, sin):
    B, L, _ = q_raw.shape
    q = q_raw.reshape(B, L, DA_HEADS, 2, DA_DH).transpose(0, 2, 3, 1, 4)
    k = k_raw.reshape(B, L, DA_HEADS, 2, DA_DH).transpose(0, 2, 3, 1, 4)
    v = v_raw.reshape(B, L, DA_HEADS, DA_DV).transpose(0, 2, 1, 3)
    q = apply_rope(q, cos, sin) * (DA_DH ** -0.5)
    k = apply_rope(k, cos, sin)
    lp = lam_params.astype(jnp.float32)
    lam = jnp.exp(jnp.sum(lp[0] * lp[1])) - jnp.exp(jnp.sum(lp[2] * lp[3])) + lambda_init
    nb = L // Q_BLOCK
    qb = jnp.moveaxis(q.reshape(B, DA_HEADS, 2, nb, Q_BLOCK, DA_DH), 3, 0)

    def block(q_blk):
        s = jnp.einsum('bhmqd,bhmkd->bhmqk', q_blk, k).astype(jnp.float32)
        p = jax.nn.softmax(s, axis=-1)
        a = p[:, :, 0] - lam * p[:, :, 1]
        return jnp.einsum('bhqk,bhkv->bhqv', a.astype(v.dtype), v)

    o = lax.map(block, qb)
    o = jnp.moveaxis(o, 0, 2).reshape(B, DA_HEADS, L, DA_DV)
    o = rms_norm(o, subln_w) * (1.0 - lambda_init)
    return o.transpose(0, 2, 1, 3).reshape(B, L, DA_WIDTH)


def conv_ffn(h, w_up, conv_w, conv_b, w_down):
    u = h @ w_up
    up = jnp.pad(u, ((0, 0), (1, 1), (0, 0)))
    c = up[:, :-2] * conv_w[0] + up[:, 1:-1] * conv_w[1] + up[:, 2:] * conv_w[2] + conv_b
    gate, val = jnp.split(c, 2, axis=-1)
    return (jax.nn.gelu(gate, approximate=True) * val) @ w_down


def _trunk(x, p, w_in, hgrn_lb_logits, hgrn_gnorm, diff_lambda, diff_subln,
           w_branch_a, w_branch_b, w_out, norm_mix_pre, norm_mix_post,
           w_up, conv_w, conv_b, w_down, norm_ffn_pre, norm_ffn_post,
           w_ple, w_ple_gate, norm_ple):
    L = x.shape[1]
    cos, sin = rope_tables(L, x.dtype)
    lb = jax.nn.softmax(hgrn_lb_logits.astype(jnp.float32), axis=0)
    lb = jnp.cumsum(lb, axis=0) - lb[0]
    splits = ([HG_WIDTH * i for i in range(1, 6)]
              + [5 * HG_WIDTH + DA_WIDTH * i for i in range(1, 4)]
              + [5 * HG_WIDTH + 3 * DA_WIDTH + D_MODEL])
    for l in range(DEPTH):
        lambda_init = 0.8 - 0.6 * math.exp(-0.3 * l)
        h = rms_norm(x, norm_mix_pre[l])
        z = h @ w_in[l]
        q_h, f_fw, f_bw, i_h, g_h, q_d, k_d, v_d, gate_a, gate_b = jnp.split(z, splits, axis=-1)
        a = hgrn2_mixer(q_h, f_fw, f_bw, i_h, g_h, lb[l], hgrn_gnorm[l])
        b = diff_attention(q_d, k_d, v_d, diff_lambda[l], lambda_init, diff_subln[l], cos, sin)
        m = jax.nn.sigmoid(gate_a) * (a @ w_branch_a[l]) + jax.nn.sigmoid(gate_b) * (b @ w_branch_b[l])
        x = x + rms_norm(m @ w_out[l], norm_mix_post[l])
        f = conv_ffn(rms_norm(x, norm_ffn_pre[l]), w_up[l], conv_w[l], conv_b[l], w_down[l])
        x = x + rms_norm(f, norm_ffn_post[l])
        e = p[l] @ w_ple[l]
        g = jax.nn.sigmoid(rms_unit(x) @ w_ple_gate[l])
        x = x + rms_norm(g * e, norm_ple[l])
    return x


def setup_inputs(seed: int = 0) -> dict:
    key = jax.random.key(seed)
    ks = jax.random.split(key, 24)

    def nrm(k, shape, s):
        return s * jax.random.normal(k, shape, jnp.float32)

    def gain(k, shape):
        return 1.0 + 0.05 * jax.random.normal(k, shape, jnp.float32)

    return {
        "x_prompt": nrm(ks[0], (BATCH, SEQ, D_MODEL), 1.0),
        "x_sample": nrm(ks[1], (DEC_BATCH, DEC_SEQ, D_MODEL), 1.0),
        "p_prompt": nrm(ks[2], (DEPTH, BATCH, SEQ, PLE_DIM), 1.0),
        "p_sample": nrm(ks[3], (DEPTH, DEC_BATCH, DEC_SEQ, PLE_DIM), 1.0),
        "w_in": nrm(ks[4], (DEPTH, D_MODEL, IN_COLS), D_MODEL ** -0.5),
        "hgrn_lb_logits": nrm(ks[5], (DEPTH, 2, HG_WIDTH), 0.1),
        "hgrn_gnorm": gain(ks[6], (DEPTH, HG_DV)),
        "diff_lambda": nrm(ks[7], (DEPTH, 4, DA_DH), 0.1),
        "diff_subln": gain(ks[8], (DEPTH, DA_DV)),
        "w_branch_a": nrm(ks[9], (DEPTH, HG_WIDTH, D_MODEL), HG_WIDTH ** -0.5),
        "w_branch_b": nrm(ks[10], (DEPTH, DA_WIDTH, D_MODEL), DA_WIDTH ** -0.5),
        "w_out": nrm(ks[11], (DEPTH, D_MODEL, D_MODEL), D_MODEL ** -0.5),
        "norm_mix_pre": gain(ks[12], (DEPTH, D_MODEL)),
        "norm_mix_post": gain(ks[13], (DEPTH, D_MODEL)),
        "w_up": nrm(ks[14], (DEPTH, D_MODEL, 2 * D_FF), D_MODEL ** -0.5),
        "conv_w": nrm(ks[15], (DEPTH, CONV_W, 2 * D_FF), CONV_W ** -0.5),
        "conv_b": nrm(ks[16], (DEPTH, 2 * D_FF), 0.01),
        "w_down": nrm(ks[17], (DEPTH, D_FF, D_MODEL), D_FF ** -0.5),
        "norm_ffn_pre": gain(ks[18], (DEPTH, D_MODEL)),
        "norm_ffn_post": gain(ks[19], (DEPTH, D_MODEL)),
        "w_ple": nrm(ks[20], (DEPTH, PLE_DIM, D_MODEL), PLE_DIM ** -0.5),
        "w_ple_gate": nrm(ks[21], (DEPTH, D_MODEL, D_MODEL), D_MODEL ** -0.5),
        "norm_ple": gain(ks[22], (DEPTH, D_MODEL)),
    }


def reference(x_prompt, x_sample, p_prompt, p_sample, w_in, hgrn_lb_logits, hgrn_gnorm,
              diff_lambda, diff_subln, w_branch_a, w_branch_b, w_out, norm_mix_pre,
              norm_mix_post, w_up, conv_w, conv_b, w_down, norm_ffn_pre, norm_ffn_post,
              w_ple, w_ple_gate, norm_ple):
    y_prompt = _trunk(x_prompt, p_prompt, w_in, hgrn_lb_logits, hgrn_gnorm, diff_lambda,
                      diff_subln, w_branch_a, w_branch_b, w_out, norm_mix_pre, norm_mix_post,
                      w_up, conv_w, conv_b, w_down, norm_ffn_pre, norm_ffn_post,
                      w_ple, w_ple_gate, norm_ple)
    y_sample = _trunk(x_sample, p_sample, w_in, hgrn_lb_logits, hgrn_gnorm, diff_lambda,
                      diff_subln, w_branch_a, w_branch_b, w_out, norm_mix_pre, norm_mix_post,
                      w_up, conv_w, conv_b, w_down, norm_ffn_pre, norm_ffn_post,
                      w_ple, w_ple_gate, norm_ple)
    return (y_prompt, y_sample)
```

```cpp
#include <hip/hip_runtime.h>
#include <hip/hip_cooperative_groups.h>
#include <cstdio>
#include <cstdint>
namespace cg = cooperative_groups;

#ifndef ONE_LAUNCH
#define ONE_LAUNCH 1
#endif

#define LAS __attribute__((address_space(3)))
typedef unsigned short bf16_t;
typedef short bf16x8 __attribute__((ext_vector_type(8)));
typedef short s16x4 __attribute__((ext_vector_type(4)));
typedef float f32x4 __attribute__((ext_vector_type(4)));
typedef float f32x16 __attribute__((ext_vector_type(16)));
typedef unsigned u32x4 __attribute__((ext_vector_type(4)));
typedef unsigned u32x2 __attribute__((ext_vector_type(2)));

constexpr int TMAX = 32768;
constexpr int NSB = 3, NL = 4, INC = 6144, FF = 2816, FF2 = 5632;
constexpr int NTOK = 81920;
constexpr float EPS = 1e-6f;
constexpr size_t SZ_WIN = (size_t)INC * 1024 * 2, SZ_WAB = (size_t)1024 * 1024 * 2, SZ_WOUT = (size_t)1024 * 1024 * 2,
                 SZ_WUP = (size_t)FF2 * 1024 * 2, SZ_WDOWN = (size_t)1024 * FF * 2, SZ_WPG = (size_t)1024 * 1280 * 2;
constexpr size_t OFF_WIN = 0, OFF_WAB = OFF_WIN + SZ_WIN, OFF_WOUT = OFF_WAB + SZ_WAB, OFF_WUP = OFF_WOUT + SZ_WOUT,
                 OFF_WDOWN = OFF_WUP + SZ_WUP, OFF_WPG = OFF_WDOWN + SZ_WDOWN, SZ_WL = OFF_WPG + SZ_WPG;
constexpr size_t OFF_LB = SZ_WL * NL, OFF_LAM = OFF_LB + 16384, OFF_COS = OFF_LAM + 256, OFF_SIN = OFF_COS + 524288;
constexpr size_t TT = (size_t)TMAX;
constexpr size_t OFF_H = OFF_SIN + 524288;
constexpr size_t OFF_QH = OFF_H + TT * 2048, OFF_GF = OFF_QH + TT * 1024, OFF_VH = OFF_GF + TT * 4096, OFF_GG = OFF_VH + TT * 1024,
                 OFF_QD = OFF_GG + TT * 1024, OFF_KD = OFF_QD + TT * 1024, OFF_VD = OFF_KD + TT * 1024, OFF_GA = OFF_VD + TT * 1024,
                 OFF_GB = OFF_GA + TT * 2048, OFF_AB = OFF_GB + TT * 2048, OFF_ST = OFF_AB + TT * 2048, OFF_DC = OFF_ST + TT * 4096,
                 OFF_M = OFF_DC + TT * 64, OFF_MO = OFF_M + TT * 2048, OFF_BAR = OFF_MO + TT * 2048, WS_END = OFF_BAR + 16384;
constexpr size_t OFF_U = OFF_QH, OFF_AP = OFF_QH, OFF_ACT = OFF_AB, OFF_OS = OFF_M;
static_assert(OFF_AB - OFF_QH >= TT * 11264 && OFF_DC - OFF_AB >= TT * 5632 && TT * 2048 >= (size_t)256 * 512 * 256, "alias spans");
constexpr int LDS_BYTES = 135168;
constexpr int PPL = 13;
constexpr int SPB = PPL * NL;
constexpr int NSTEPS = 1 + NSB * SPB;

struct Params {
  const float* x_prompt; const float* x_sample; const float* p_prompt; const float* p_sample;
  const float* w_in; const float* lb_logits; const float* gnorm; const float* dlam; const float* subln;
  const float* w_a; const float* w_b; const float* w_out; const float* n_mix_pre; const float* n_mix_post;
  const float* w_up; const float* conv_w; const float* conv_b; const float* w_down; const float* n_ffn_pre; const float* n_ffn_post;
  const float* w_ple; const float* w_pg; const float* n_ple;
  float* out; unsigned char* ws;
};

typedef __bf16 bf16x2_t __attribute__((ext_vector_type(2)));
typedef float f32x2_t __attribute__((ext_vector_type(2)));
__device__ __forceinline__ unsigned cvtpk(float lo, float hi) { f32x2_t v = {lo, hi}; bf16x2_t b = __builtin_convertvector(v, bf16x2_t); return __builtin_bit_cast(unsigned, b); }
__device__ __forceinline__ float bf2f(unsigned short b) { return __uint_as_float(((unsigned)b) << 16); }
__device__ __forceinline__ float bflo(unsigned w) { return __uint_as_float(w << 16); }
__device__ __forceinline__ float bfhi(unsigned w) { return __uint_as_float(w & 0xffff0000u); }
__device__ __forceinline__ unsigned short f2bf(float f) { return (unsigned short)(cvtpk(f, 0.f) & 0xffffu); }
__device__ __forceinline__ float fexp(float x) { return __builtin_amdgcn_exp2f(x * 1.4426950408889634f); }
__device__ __forceinline__ float sigm(float x) { return __builtin_amdgcn_rcpf(1.f + fexp(-x)); }
__device__ __forceinline__ f32x4 mfma16(bf16x8 a, bf16x8 b, f32x4 c) { return __builtin_amdgcn_mfma_f32_16x16x32_bf16(a, b, c, 0, 0, 0); }
__device__ __forceinline__ int otid() { int t = threadIdx.x; asm volatile("" : "+v"(t)); return t; }
__device__ __forceinline__ int obid() { int t = blockIdx.x; asm volatile("" : "+s"(t)); return t; }
__device__ __forceinline__ float wave_sum(float v) {
#pragma unroll
  for (int o = 32; o >= 1; o >>= 1) v += __shfl_xor(v, o, 64);
  return v;
}

namespace pg8 {
constexpr int BM = 256, BK = 64, HALF = 128, HTB = HALF * BK * 2, STAGE_BYTES = 8 * HTB, NXCD = 8, WGM = 8;
__device__ __forceinline__ int lds_byte(int r, int c) { const int st = (r >> 4) * 2 + (c >> 5), rr = r & 15, cc = c & 31, ob = rr * 64 + cc * 2; return st * 1024 + (ob ^ (((ob >> 9) & 1) << 5)); }
__device__ __forceinline__ void stage_rc(int b, int& R, int& C) { const int st = b / 1024, sb = b % 1024, swz = sb ^ (((sb >> 9) & 1) << 5); R = (st >> 1) * 16 + swz / 64; C = (st & 1) * 32 + (swz % 64) / 2; }
struct Unit { int pm, pn; };
struct Gemm { const bf16_t* A; const bf16_t* Bt; int lda, ldb, M, N, K; };
struct StaticOrder {
  int nM, nN, nwg, G, c;
  __device__ void init(int M, int N, int G_, int c_) { nM = M / BM; nN = N / BM; nwg = nM * nN; G = G_; c = c_; }
  __device__ bool next(int i, Unit& u) const {
    const long L = (long)i * G + c; if (L >= nwg) return false;
    int wgid = (int)L; { const int q = nwg / NXCD, r = nwg % NXCD, xcd = wgid % NXCD, off = wgid / NXCD; wgid = (xcd < r ? xcd * (q + 1) : r * (q + 1) + (xcd - r) * q) + off; }
    const int nig = WGM * nN, gid = wgid / nig, fm = gid * WGM, gsz = (nM - fm) < WGM ? (nM - fm) : WGM;
    u.pm = fm + ((wgid % nig) % gsz); u.pn = (wgid % nig) / gsz; return true;
  }
};

template <class Epi, bool HOOK>
__device__ __forceinline__ void gemm_phase(LAS unsigned char* lds, const Gemm g, const StaticOrder& S, const Epi& E, const int hook_t) {
  const int tid = otid(), wid = __builtin_amdgcn_readfirstlane(tid >> 6), lane = tid & 63, wr = wid >> 2, wc = wid & 3, fr = lane & 15, fq = lane >> 4;
  const int K = g.K, nt = K / BK;
  unsigned voffA[2], voffB[2];
#pragma unroll
  for (int i = 0; i < 2; ++i) { int R, C; stage_rc(tid * 16 + i * 8192, R, C);
    voffA[i] = (unsigned)(R * g.lda + C) * 2u; voffB[i] = (unsigned)(R * g.ldb + C) * 2u; }
  const size_t kstep = (size_t)(BK * 2);
  const size_t hstepA = (size_t)HALF * g.lda * 2, hstepB = (size_t)HALF * g.ldb * 2;
  const size_t tstepA = 2 * hstepA, tstepB = 2 * hstepB;
  const unsigned ldsw = (unsigned)wid * 1024u;
  const int aoff = lds_byte(wr * 64 + fr, fq * 8), boff = lds_byte(wc * 32 + fr, fq * 8);
#define PG8_SA(b, h) (((b) * 2 + (h)) * HTB)
#define PG8_SB(b, h) ((4 + (b) * 2 + (h)) * HTB)
#define PG8_STAGE(bufoff, gbase, voff) do { _Pragma("unroll") for (int _i = 0; _i < 2; ++_i) \
    __builtin_amdgcn_global_load_lds((const unsigned*)((const char*)(gbase) + (voff)[_i]), (LAS unsigned*)(lds + (bufoff) + ldsw + _i * 8192), 16, 0, 0); } while (0)
#define PG8_LDA(dst, b, h) do { _Pragma("unroll") for (int m = 0; m < 4; ++m) _Pragma("unroll") for (int k = 0; k < 2; ++k) dst[m][k] = *(const LAS bf16x8*)(lds + PG8_SA(b, h) + aoff + m * 2048 + k * 1024); } while (0)
#define PG8_LDB(dst, b, h) do { _Pragma("unroll") for (int n = 0; n < 2; ++n) _Pragma("unroll") for (int k = 0; k < 2; ++k) dst[n][k] = *(const LAS bf16x8*)(lds + PG8_SB(b, h) + boff + n * 2048 + k * 1024); } while (0)
#define PG8_MMA(ai, bj, At, Bt) do { __builtin_amdgcn_s_setprio(1); _Pragma("unroll") for (int m = 0; m < 4; ++m) _Pragma("unroll") for (int n = 0; n < 2; ++n) _Pragma("unroll") for (int k = 0; k < 2; ++k) \
    acc[ai][bj][m][n] = __builtin_amdgcn_mfma_f32_16x16x32_bf16(Bt[n][k], At[m][k], acc[ai][bj][m][n], 0, 0, 0); __builtin_amdgcn_s_setprio(0); } while (0)
#define PG8_WAIT_V(n) asm volatile("s_waitcnt vmcnt(" #n ")" ::: "memory")
#define PG8_WAIT_L(n) asm volatile("s_waitcnt lgkmcnt(" #n ")" ::: "memory")
#define PG8_BAR __builtin_amdgcn_s_barrier()
#define PG8_SCHED __builtin_amdgcn_sched_barrier(0)
  Unit cur, nxt; int ui = 0;
  if (!S.next(0, cur)) return;
  f32x4 acc[2][2][4][2];
#pragma unroll
  for (int a = 0; a < 2; ++a)
#pragma unroll
    for (int b = 0; b < 2; ++b)
#pragma unroll
      for (int m = 0; m < 4; ++m)
#pragma unroll
        for (int n = 0; n < 2; ++n) acc[a][b][m][n] = (f32x4){0.f, 0.f, 0.f, 0.f};
  bf16x8 At[4][2], B0[2][2], B1[2][2];
  const char* cA = (const char*)g.A + (size_t)cur.pm * tstepA; const char* cB = (const char*)g.Bt + (size_t)cur.pn * tstepB;
  PG8_STAGE(PG8_SB(0, 0), cB, voffB); PG8_STAGE(PG8_SA(0, 0), cA, voffA); PG8_STAGE(PG8_SB(0, 1), cB + hstepB, voffB); PG8_STAGE(PG8_SA(0, 1), cA + hstepA, voffA);
  if (wr == 1) PG8_BAR;
  PG8_WAIT_V(4); PG8_BAR;
  PG8_STAGE(PG8_SB(1, 0), cB + kstep, voffB); PG8_STAGE(PG8_SA(1, 0), cA + kstep, voffA); PG8_STAGE(PG8_SB(1, 1), cB + hstepB + kstep, voffB);
  PG8_WAIT_V(6); PG8_BAR;
  for (;;) {
    const bool has_next = S.next(ui + 1, nxt);
    const char* nA = has_next ? (const char*)g.A + (size_t)nxt.pm * tstepA : cA; const char* nB = has_next ? (const char*)g.Bt + (size_t)nxt.pn * tstepB : cB;
    for (int t = 0; t < nt; t += 2) {
      const bool last = (t == nt - 2);
      const char* a1 = cA + (size_t)(t + 1) * kstep;
      const char* a2 = last ? nA : cA + (size_t)(t + 2) * kstep; const char* b2 = last ? nB : cB + (size_t)(t + 2) * kstep;
      const char* a3 = a2 + kstep; const char* b3 = b2 + kstep;
      if (HOOK) { if (t == hook_t) E.hook(acc, cur.pm, cur.pn, wr, wc, fr, fq); }
      PG8_LDB(B0, 0, 0); PG8_SCHED; PG8_LDA(At, 0, 0); PG8_STAGE(PG8_SA(1, 1), a1 + hstepA, voffA);
      PG8_WAIT_L(8); PG8_BAR; PG8_WAIT_L(0); PG8_MMA(0, 0, At, B0); PG8_BAR; PG8_SCHED;
      PG8_LDB(B1, 0, 1); PG8_STAGE(PG8_SB(0, 0), b2, voffB);
      PG8_BAR; PG8_WAIT_L(0); PG8_MMA(0, 1, At, B1); PG8_BAR;
      PG8_LDA(At, 0, 1); PG8_STAGE(PG8_SA(0, 0), a2, voffA);
      PG8_BAR; PG8_WAIT_L(0); PG8_MMA(1, 0, At, B0); PG8_BAR; PG8_SCHED;
      PG8_STAGE(PG8_SB(0, 1), b2 + hstepB, voffB);
      PG8_WAIT_V(6); PG8_BAR; PG8_MMA(1, 1, At, B1); PG8_BAR;
      PG8_LDB(B0, 1, 0); PG8_SCHED; PG8_LDA(At, 1, 0); PG8_STAGE(PG8_SA(0, 1), a2 + hstepA, voffA);
      PG8_WAIT_L(8); PG8_BAR; PG8_WAIT_L(0); PG8_MMA(0, 0, At, B0); PG8_BAR; PG8_SCHED;
      PG8_LDB(B1, 1, 1); PG8_STAGE(PG8_SB(1, 0), b3, voffB);
      PG8_BAR; PG8_WAIT_L(0); PG8_MMA(0, 1, At, B1); PG8_BAR;
      PG8_LDA(At, 1, 1); PG8_STAGE(PG8_SA(1, 0), a3, voffA);
      PG8_BAR; PG8_WAIT_L(0); PG8_MMA(1, 0, At, B0); PG8_BAR; PG8_SCHED;
      PG8_STAGE(PG8_SB(1, 1), b3 + hstepB, voffB);
      PG8_WAIT_V(6); PG8_BAR; PG8_MMA(1, 1, At, B1); PG8_BAR;
    }
    E(acc, cur.pm, cur.pn, wr, wc, fr, fq);
    if (!has_next) break;
#pragma unroll
    for (int a = 0; a < 2; ++a)
#pragma unroll
      for (int b = 0; b < 2; ++b)
#pragma unroll
        for (int m = 0; m < 4; ++m)
#pragma unroll
          for (int n = 0; n < 2; ++n) acc[a][b][m][n] = (f32x4){0.f, 0.f, 0.f, 0.f};
    cur = nxt; cA = nA; cB = nB; ++ui;
  }
  PG8_WAIT_V(0);
  if (wr == 0) PG8_BAR;
  PG8_BAR;
#undef PG8_SA
#undef PG8_SB
#undef PG8_STAGE
#undef PG8_LDA
#undef PG8_LDB
#undef PG8_MMA
#undef PG8_WAIT_V
#undef PG8_WAIT_L
#undef PG8_BAR
#undef PG8_SCHED
}
}

typedef f32x4 AccT[2][2][4][2];

struct EpiPlain {
  bf16_t* C; int ldc;
  __device__ __forceinline__ void hook(AccT& acc, int pm, int pn, int wr, int wc, int fr, int fq) const {}
  __device__ __forceinline__ void operator()(const AccT& acc, int pm, int pn, int wr, int wc, int fr, int fq) const {
    const int row0 = pm * 256 + wr * 64 + fr, col0 = pn * 256 + wc * 32 + 8 * fq;
#pragma unroll
    for (int ai = 0; ai < 2; ++ai)
#pragma unroll
      for (int m = 0; m < 4; ++m) { bf16_t* rowp = C + (size_t)(row0 + ai * 128 + m * 16) * ldc + col0;
#pragma unroll
        for (int bj = 0; bj < 2; ++bj) { const f32x4 v0 = acc[ai][bj][m][0], v1 = acc[ai][bj][m][1];
          u32x4 w = {cvtpk(v0[0], v0[1]), cvtpk(v0[2], v0[3]), cvtpk(v1[0], v1[1]), cvtpk(v1[2], v1[3])}; *(u32x4*)(rowp + bj * 128) = w; } }
  }
};

struct EpiWin {
  unsigned char* ws; int l; int Lmask;
  __device__ __forceinline__ void hook(AccT& acc, int pm, int pn, int wr, int wc, int fr, int fq) const {}
  __device__ __forceinline__ void operator()(const AccT& acc, int pm, int pn, int wr, int wc, int fr, int fq) const {
    const int row0 = pm * 256 + wr * 64 + fr;
    if (pn >= 16) {
      bf16_t* G = (bf16_t*)(ws + (((pn - 16) >> 2) ? OFF_GB : OFF_GA));
      const int col0 = ((pn - 16) & 3) * 256 + wc * 32 + 8 * fq;
#pragma unroll
      for (int ai = 0; ai < 2; ++ai)
#pragma unroll
        for (int m = 0; m < 4; ++m) { bf16_t* rowp = G + (size_t)(row0 + ai * 128 + m * 16) * 1024 + col0;
#pragma unroll
          for (int bj = 0; bj < 2; ++bj) { const f32x4 v0 = acc[ai][bj][m][0], v1 = acc[ai][bj][m][1];
            u32x4 w = {cvtpk(sigm(v0[0]), sigm(v0[1])), cvtpk(sigm(v0[2]), sigm(v0[3])), cvtpk(sigm(v1[0]), sigm(v1[1])), cvtpk(sigm(v1[2]), sigm(v1[3]))};
            *(u32x4*)(rowp + bj * 128) = w; } }
      return;
    }
    const int seg = pn >> 1;
    const int cin = (pn & 1) * 256 + wc * 32 + 8 * fq;
    if (seg == 1 || seg == 2) {
      const int dir = seg - 1;
      float* GF = (float*)(ws + OFF_GF);
      const float* LB = (const float*)(ws + OFF_LB) + l * 1024 + dir * 512;
#pragma unroll
      for (int bj = 0; bj < 2; ++bj)
#pragma unroll
        for (int n = 0; n < 2; ++n) { const int c = cin + bj * 128 + n * 4; const f32x4 lb = *(const f32x4*)(LB + c);
#pragma unroll
          for (int ai = 0; ai < 2; ++ai)
#pragma unroll
            for (int m = 0; m < 4; ++m) { const f32x4 v = acc[ai][bj][m][n]; f32x4 o;
#pragma unroll
              for (int j = 0; j < 4; ++j) o[j] = __logf(fmaxf(lb[j], 1e-30f) + (1.f - lb[j]) * sigm(v[j]));
              *(f32x4*)(GF + (size_t)(row0 + ai * 128 + m * 16) * 1024 + dir * 512 + c) = o; } }
      return;
    }
    if (seg == 5 || seg == 6) {
      bf16_t* dst = (bf16_t*)(ws + (seg == 5 ? OFF_QD : OFF_KD));
      const float sc = seg == 5 ? 0.125f : 1.f;
      const float* COS = (const float*)(ws + OFF_COS); const float* SIN = (const float*)(ws + OFF_SIN);
      const int jj = 8 * fq;
#pragma unroll
      for (int ai = 0; ai < 2; ++ai)
#pragma unroll
        for (int m = 0; m < 4; ++m) { const int row = row0 + ai * 128 + m * 16; const int pos = row & Lmask;
          float o1[8], o2[8];
#pragma unroll
          for (int n = 0; n < 2; ++n) { const f32x4 cs = *(const f32x4*)(COS + pos * 32 + jj + 4 * n), sn = *(const f32x4*)(SIN + pos * 32 + jj + 4 * n);
            const f32x4 x1 = acc[ai][0][m][n], x2 = acc[ai][1][m][n];
#pragma unroll
            for (int j = 0; j < 4; ++j) { o1[4 * n + j] = (x1[j] * cs[j] - x2[j] * sn[j]) * sc; o2[4 * n + j] = (x2[j] * cs[j] + x1[j] * sn[j]) * sc; } }
          bf16_t* bp = dst + (size_t)row * 512 + (pn & 1) * 256 + wc * 64 + jj;
          u32x4 w1 = {cvtpk(o1[0], o1[1]), cvtpk(o1[2], o1[3]), cvtpk(o1[4], o1[5]), cvtpk(o1[6], o1[7])};
          u32x4 w2 = {cvtpk(o2[0], o2[1]), cvtpk(o2[2], o2[3]), cvtpk(o2[4], o2[5]), cvtpk(o2[6], o2[7])};
          *(u32x4*)bp = w1; *(u32x4*)(bp + 32) = w2; }
      return;
    }
    bf16_t* dst = (bf16_t*)(ws + (seg == 0 ? OFF_QH : seg == 3 ? OFF_VH : seg == 4 ? OFF_GG : OFF_VD));
    const int mode = seg == 0 ? 1 : (seg == 4 ? 2 : 0);
#pragma unroll
    for (int ai = 0; ai < 2; ++ai)
#pragma unroll
      for (int m = 0; m < 4; ++m) { bf16_t* rowp = dst + (size_t)(row0 + ai * 128 + m * 16) * 512 + cin;
#pragma unroll
        for (int bj = 0; bj < 2; ++bj) { f32x4 v0 = acc[ai][bj][m][0], v1 = acc[ai][bj][m][1];
          if (mode) {
#pragma unroll
            for (int j = 0; j < 4; ++j) { v0[j] = v0[j] * sigm(v0[j]) * (mode == 1 ? 0.08838834764831845f : 1.f); v1[j] = v1[j] * sigm(v1[j]) * (mode == 1 ? 0.08838834764831845f : 1.f); } }
          u32x4 w = {cvtpk(v0[0], v0[1]), cvtpk(v0[2], v0[3]), cvtpk(v1[0], v1[1]), cvtpk(v1[2], v1[3])}; *(u32x4*)(rowp + bj * 128) = w; } }
  }
};

template <int SECOND> struct EpiGate {
  const bf16_t* G; bf16_t* M;
  __device__ __forceinline__ void hook(AccT& acc, int pm, int pn, int wr, int wc, int fr, int fq) const {}
  __device__ __forceinline__ void operator()(const AccT& acc, int pm, int pn, int wr, int wc, int fr, int fq) const {
    const unsigned voff = (unsigned)(fr * 1024 + 8 * fq) * 2u;
    const size_t ub = ((size_t)(pm * 256 + wr * 64) * 1024 + pn * 256 + wc * 32) * 2;
#pragma unroll
    for (int ai = 0; ai < 2; ++ai)
#pragma unroll
      for (int m = 0; m < 4; ++m) { const char* gb = (const char*)G + ub + (size_t)(ai * 128 + m * 16) * 2048; char* mo = (char*)M + ub + (size_t)(ai * 128 + m * 16) * 2048;
#pragma unroll
        for (int bj = 0; bj < 2; ++bj) { const u32x4 b = *(const u32x4*)(gb + voff + bj * 256); const f32x4 v0 = acc[ai][bj][m][0], v1 = acc[ai][bj][m][1];
          float r[8] = {v0[0] * bflo(b[0]), v0[1] * bfhi(b[0]), v0[2] * bflo(b[1]), v0[3] * bfhi(b[1]), v1[0] * bflo(b[2]), v1[1] * bfhi(b[2]), v1[2] * bflo(b[3]), v1[3] * bfhi(b[3])};
          if (SECOND) { const u32x4 pm_ = *(const u32x4*)(mo + voff + bj * 256);
#pragma unroll
            for (int q = 0; q < 4; ++q) { r[2 * q] += bflo(pm_[q]); r[2 * q + 1] += bfhi(pm_[q]); } }
          u32x4 w = {cvtpk(r[0], r[1]), cvtpk(r[2], r[3]), cvtpk(r[4], r[5]), cvtpk(r[6], r[7])};
          *(u32x4*)(mo + voff + bj * 256) = w; } }
  }
};

struct EpiMerge {
  const bf16_t* GA; const bf16_t* GB; bf16_t* M;
  __device__ __forceinline__ void hook(AccT& acc, int pm, int pn, int wr, int wc, int fr, int fq) const {
    const int t_ = otid();
    const unsigned voff = (unsigned)((t_ & 15) * 1024 + 8 * ((t_ >> 4) & 3)) * 2u;
    const size_t ub = ((size_t)(pm * 256 + wr * 64) * 1024 + pn * 256 + wc * 32) * 2;
#pragma unroll
    for (int ai = 0; ai < 2; ++ai)
#pragma unroll
      for (int m = 0; m < 4; ++m) { const char* ga = (const char*)GA + ub + (size_t)(ai * 128 + m * 16) * 2048; const char* gb = (const char*)GB + ub + (size_t)(ai * 128 + m * 16) * 2048;
#pragma unroll
        for (int bj = 0; bj < 2; ++bj) { const u32x4 a = __builtin_nontemporal_load((const u32x4*)(ga + voff + bj * 256)), b = *(const u32x4*)(gb + voff + bj * 256);
          f32x4 v0 = acc[ai][bj][m][0], v1 = acc[ai][bj][m][1];
          v0[0] *= bflo(a[0]) * __builtin_amdgcn_rcpf(fmaxf(bflo(b[0]), 1e-30f)); v0[1] *= bfhi(a[0]) * __builtin_amdgcn_rcpf(fmaxf(bfhi(b[0]), 1e-30f));
          v0[2] *= bflo(a[1]) * __builtin_amdgcn_rcpf(fmaxf(bflo(b[1]), 1e-30f)); v0[3] *= bfhi(a[1]) * __builtin_amdgcn_rcpf(fmaxf(bfhi(b[1]), 1e-30f));
          v1[0] *= bflo(a[2]) * __builtin_amdgcn_rcpf(fmaxf(bflo(b[2]), 1e-30f)); v1[1] *= bfhi(a[2]) * __builtin_amdgcn_rcpf(fmaxf(bfhi(b[2]), 1e-30f));
          v1[2] *= bflo(a[3]) * __builtin_amdgcn_rcpf(fmaxf(bflo(b[3]), 1e-30f)); v1[3] *= bfhi(a[3]) * __builtin_amdgcn_rcpf(fmaxf(bfhi(b[3]), 1e-30f));
          acc[ai][bj][m][0] = v0; acc[ai][bj][m][1] = v1; __builtin_amdgcn_sched_barrier(0); } }
  }
  __device__ __forceinline__ void operator()(const AccT& acc, int pm, int pn, int wr, int wc, int fr, int fq) const {
    const int t_ = otid();
    const unsigned voff = (unsigned)((t_ & 15) * 1024 + 8 * ((t_ >> 4) & 3)) * 2u;
    const size_t ub = ((size_t)(pm * 256 + wr * 64) * 1024 + pn * 256 + wc * 32) * 2;
#pragma unroll
    for (int ai = 0; ai < 2; ++ai)
#pragma unroll
      for (int m = 0; m < 4; ++m) { const char* gb = (const char*)GB + ub + (size_t)(ai * 128 + m * 16) * 2048; char* mo = (char*)M + ub + (size_t)(ai * 128 + m * 16) * 2048;
#pragma unroll
        for (int bj = 0; bj < 2; ++bj) { const u32x4 b = *(const u32x4*)(gb + voff + bj * 256); const f32x4 v0 = acc[ai][bj][m][0], v1 = acc[ai][bj][m][1];
          u32x4 w = {cvtpk(v0[0] * bflo(b[0]), v0[1] * bfhi(b[0])), cvtpk(v0[2] * bflo(b[1]), v0[3] * bfhi(b[1])), cvtpk(v1[0] * bflo(b[2]), v1[1] * bfhi(b[2])), cvtpk(v1[2] * bflo(b[3]), v1[3] * bfhi(b[3]))};
          *(u32x4*)(mo + voff + bj * 256) = w; } }
  }
};

struct EpiPle {
  bf16_t* GE;
  __device__ __forceinline__ void hook(AccT& acc, int pm, int pn, int wr, int wc, int fr, int fq) const {
    const int row0 = pm * 256 + wr * 64 + fr, col0 = pn * 256 + wc * 32 + 8 * fq;
#pragma unroll
    for (int ai = 0; ai < 2; ++ai)
#pragma unroll
      for (int m = 0; m < 4; ++m) { const size_t ro = (size_t)(row0 + ai * 128 + m * 16) * 1024 + col0;
#pragma unroll
        for (int bj = 0; bj < 2; ++bj) { const f32x4 v0 = acc[ai][bj][m][0], v1 = acc[ai][bj][m][1];
          u32x4 w = {cvtpk(v0[0], v0[1]), cvtpk(v0[2], v0[3]), cvtpk(v1[0], v1[1]), cvtpk(v1[2], v1[3])};
          *(u32x4*)(GE + ro + bj * 128) = w; acc[ai][bj][m][0] = (f32x4){0.f, 0.f, 0.f, 0.f}; acc[ai][bj][m][1] = (f32x4){0.f, 0.f, 0.f, 0.f}; } }
  }
  __device__ __forceinline__ void operator()(const AccT& acc, int pm, int pn, int wr, int wc, int fr, int fq) const {
    const int row0 = pm * 256 + wr * 64 + fr, col0 = pn * 256 + wc * 32 + 8 * fq;
#pragma unroll
    for (int ai = 0; ai < 2; ++ai)
#pragma unroll
      for (int m = 0; m < 4; ++m) { const size_t ro = (size_t)(row0 + ai * 128 + m * 16) * 1024 + col0;
#pragma unroll
        for (int bj = 0; bj < 2; ++bj) { const u32x4 e = __builtin_nontemporal_load((const u32x4*)(GE + ro + bj * 128)); const f32x4 v0 = acc[ai][bj][m][0], v1 = acc[ai][bj][m][1];
          u32x4 w = {cvtpk(sigm(v0[0]) * bflo(e[0]), sigm(v0[1]) * bfhi(e[0])), cvtpk(sigm(v0[2]) * bflo(e[1]), sigm(v0[3]) * bfhi(e[1])),
                     cvtpk(sigm(v1[0]) * bflo(e[2]), sigm(v1[1]) * bfhi(e[2])), cvtpk(sigm(v1[2]) * bflo(e[3]), sigm(v1[3]) * bfhi(e[3]))};
          *(u32x4*)(GE + ro + bj * 128) = w; } }
  }
};

__device__ __forceinline__ void transpose_tile(const float* __restrict__ src, int N, bf16_t* __restrict__ dst, int ldb, int koff, int kt, int ntile, int perm_mode, float* ldsf) {
  const int tid = otid();
  const int k0 = kt * 64, n0 = ntile * 64;
  { const int r = tid >> 4, c4 = (tid & 15) * 4;
#pragma unroll
    for (int h = 0; h < 2; ++h) { const int rr = r + h * 32; const f32x4 v = __builtin_nontemporal_load((const f32x4*)(src + (size_t)(k0 + rr) * N + n0 + c4));
      ldsf[rr * 65 + c4 + 0] = v[0]; ldsf[rr * 65 + c4 + 1] = v[1]; ldsf[rr * 65 + c4 + 2] = v[2]; ldsf[rr * 65 + c4 + 3] = v[3]; } }
  __syncthreads();
  { const int n = tid >> 3, k8 = (tid & 7) * 8;
    float v[8];
#pragma unroll
    for (int i = 0; i < 8; ++i) v[i] = ldsf[(k8 + i) * 65 + n];
    int c = n0 + n;
    const bool rope_cols = (perm_mode == 3) && c >= 2560 && c < 3584;
    if (rope_cols) { const int cl = c & 255, b = cl >> 6, half = (cl >> 5) & 1, jj = cl & 31;
      c = (c & ~255) + 128 * half + 32 * b + 16 * ((jj >> 2) & 1) + 4 * ((jj >> 3) & 3) + (jj & 3); }
    if (perm_mode == 2 || (perm_mode == 3 && !rope_cols)) c = (c & ~31) + 16 * ((c >> 2) & 1) + 4 * ((c >> 3) & 3) + (c & 3);
    u32x4 w = {cvtpk(v[0], v[1]), cvtpk(v[2], v[3]), cvtpk(v[4], v[5]), cvtpk(v[6], v[7])};
    *(u32x4*)(dst + (size_t)c * ldb + koff + k0 + k8) = w; }
  __syncthreads();
}

__device__ void prep_phase(const Params& p, unsigned char* smem) {
  float* ldsf = (float*)smem;
  const int TPL = 4480;
  for (int tl = blockIdx.x; tl < TPL * NL; tl += gridDim.x) {
    const int l = tl / TPL; int r = tl % TPL;
    unsigned char* wl = p.ws + (size_t)l * SZ_WL;
    if (r < 1536) { transpose_tile(p.w_in + (size_t)l * 1024 * INC, INC, (bf16_t*)(wl + OFF_WIN), 1024, 0, r / 96, r % 96, 3, ldsf); continue; } r -= 1536;
    if (r < 128) { transpose_tile(p.w_a + (size_t)l * 512 * 1024, 1024, (bf16_t*)(wl + OFF_WAB), 1024, 0, r / 16, r % 16, 2, ldsf); continue; } r -= 128;
    if (r < 128) { transpose_tile(p.w_b + (size_t)l * 512 * 1024, 1024, (bf16_t*)(wl + OFF_WAB), 1024, 512, r / 16, r % 16, 2, ldsf); continue; } r -= 128;
    if (r < 256) { transpose_tile(p.w_out + (size_t)l * 1024 * 1024, 1024, (bf16_t*)(wl + OFF_WOUT), 1024, 0, r / 16, r % 16, 2, ldsf); continue; } r -= 256;
    if (r < 1408) { transpose_tile(p.w_up + (size_t)l * 1024 * FF2, FF2, (bf16_t*)(wl + OFF_WUP), 1024, 0, r / 88, r % 88, 2, ldsf); continue; } r -= 1408;
    if (r < 704) { transpose_tile(p.w_down + (size_t)l * FF * 1024, 1024, (bf16_t*)(wl + OFF_WDOWN), FF, 0, r / 16, r % 16, 2, ldsf); continue; } r -= 704;
    if (r < 64) { transpose_tile(p.w_ple + (size_t)l * 256 * 1024, 1024, (bf16_t*)(wl + OFF_WPG), 1280, 0, r / 16, r % 16, 2, ldsf); continue; } r -= 64;
    transpose_tile(p.w_pg + (size_t)l * 1024 * 1024, 1024, (bf16_t*)(wl + OFF_WPG), 1280, 256, r / 16, r % 16, 2, ldsf);
  }
  const int gt = obid() * 512 + otid(), gn = gridDim.x * 512;
  float* LB = (float*)(p.ws + OFF_LB); float* LAM = (float*)(p.ws + OFF_LAM);
  float* COS = (float*)(p.ws + OFF_COS); float* SIN = (float*)(p.ws + OFF_SIN);
  for (int i = gt; i < 1024; i += gn) {
    const float x0 = p.lb_logits[i], x1 = p.lb_logits[1024 + i], x2 = p.lb_logits[2048 + i], x3 = p.lb_logits[3072 + i];
    const float mx = fmaxf(fmaxf(x0, x1), fmaxf(x2, x3));
    const float e0 = expf(x0 - mx), e1 = expf(x1 - mx), e2 = expf(x2 - mx), e3 = expf(x3 - mx), s = e0 + e1 + e2 + e3;
    LB[i] = 0.f; LB[1024 + i] = e1 / s; LB[2048 + i] = (e1 + e2) / s; LB[3072 + i] = (e1 + e2 + e3) / s;
  }
  if (gt < NL) {
    const float* lp = p.dlam + gt * 256; float d1 = 0.f, d2 = 0.f;
    for (int i = 0; i < 64; ++i) { d1 += lp[i] * lp[64 + i]; d2 += lp[128 + i] * lp[192 + i]; }
    const float li = 0.8f - 0.6f * expf(-0.3f * (float)gt);
    LAM[gt] = expf(d1) - expf(d2) + li; LAM[8 + gt] = 1.f - li;
  }
  for (int i = gt; i < 4096 * 32; i += gn) {
    const int pos = i >> 5, j = i & 31;
    const float inv = 1.0f / exp2f((float)j * (13.287712379549449f / 32.f));
    const float ang = (float)pos * inv;
    double rev = (double)ang * 0.15915494309189535; rev -= rint(rev);
    COS[i] = __builtin_amdgcn_cosf((float)rev); SIN[i] = __builtin_amdgcn_sinf((float)rev);
  }
}

__device__ void rowwise_phase(const float* __restrict__ xin, float* __restrict__ xres, const bf16_t* __restrict__ y, const float* __restrict__ w_post,
                              const float* __restrict__ w_next, bool do_next, bf16_t* __restrict__ Hout, int ldh, int hoff, const float* __restrict__ p_src, int T, bool final_f32) {
  const int tid_ = otid(); const int wid = tid_ >> 6, lane = tid_ & 63;
  for (int row = obid() * 8 + wid; row < T; row += gridDim.x * 8) {
    float x[16];
    if (y) {
#pragma unroll
      for (int c = 0; c < 2; ++c) { const u32x4 w = *(const u32x4*)((const bf16_t*)(xres + (size_t)row * 1024) + c * 512 + lane * 8);
#pragma unroll
        for (int i = 0; i < 4; ++i) { x[c * 8 + 2 * i] = bflo(w[i]); x[c * 8 + 2 * i + 1] = bfhi(w[i]); } }
    } else {
#pragma unroll
      for (int c = 0; c < 2; ++c) { const float* xp = xin + (size_t)row * 1024 + c * 512 + lane * 8;
        const f32x4 a = __builtin_nontemporal_load((const f32x4*)xp), b = __builtin_nontemporal_load((const f32x4*)(xp + 4));
        x[c * 8 + 0] = a[0]; x[c * 8 + 1] = a[1]; x[c * 8 + 2] = a[2]; x[c * 8 + 3] = a[3]; x[c * 8 + 4] = b[0]; x[c * 8 + 5] = b[1]; x[c * 8 + 6] = b[2]; x[c * 8 + 7] = b[3]; }
    }
    if (y) {
      float yv[16]; float ss = 0.f;
#pragma unroll
      for (int c = 0; c < 2; ++c) { const u32x4 w = __builtin_nontemporal_load((const u32x4*)(y + (size_t)row * 1024 + c * 512 + lane * 8));
#pragma unroll
        for (int i = 0; i < 4; ++i) { yv[c * 8 + 2 * i] = bflo(w[i]); yv[c * 8 + 2 * i + 1] = bfhi(w[i]); } }
#pragma unroll
      for (int i = 0; i < 16; ++i) ss += yv[i] * yv[i];
      ss = wave_sum(ss);
      const float rs = rsqrtf(ss * (1.f / 1024.f) + EPS);
#pragma unroll
      for (int c = 0; c < 2; ++c) { const float* wp = w_post + c * 512 + lane * 8; const f32x4 a = *(const f32x4*)wp, b = *(const f32x4*)(wp + 4);
        x[c * 8 + 0] += yv[c * 8 + 0] * rs * a[0]; x[c * 8 + 1] += yv[c * 8 + 1] * rs * a[1]; x[c * 8 + 2] += yv[c * 8 + 2] * rs * a[2]; x[c * 8 + 3] += yv[c * 8 + 3] * rs * a[3];
        x[c * 8 + 4] += yv[c * 8 + 4] * rs * b[0]; x[c * 8 + 5] += yv[c * 8 + 5] * rs * b[1]; x[c * 8 + 6] += yv[c * 8 + 6] * rs * b[2]; x[c * 8 + 7] += yv[c * 8 + 7] * rs * b[3]; }
    }
    if (final_f32) {
#pragma unroll
      for (int c = 0; c < 2; ++c) { float* xp = xres + (size_t)row * 1024 + c * 512 + lane * 8;
        __builtin_nontemporal_store((f32x4){x[c * 8 + 0], x[c * 8 + 1], x[c * 8 + 2], x[c * 8 + 3]}, (f32x4*)xp); __builtin_nontemporal_store((f32x4){x[c * 8 + 4], x[c * 8 + 5], x[c * 8 + 6], x[c * 8 + 7]}, (f32x4*)(xp + 4)); }
    } else {
#pragma unroll
      for (int c = 0; c < 2; ++c) { u32x4 w;
#pragma unroll
        for (int i = 0; i < 4; ++i) w[i] = cvtpk(x[c * 8 + 2 * i], x[c * 8 + 2 * i + 1]);
        *(u32x4*)((bf16_t*)(xres + (size_t)row * 1024) + c * 512 + lane * 8) = w; }
    }
    if (do_next) {
      float s2 = 0.f;
#pragma unroll
      for (int i = 0; i < 16; ++i) s2 += x[i] * x[i];
      s2 = wave_sum(s2);
      const float r2 = rsqrtf(s2 * (1.f / 1024.f) + EPS);
#pragma unroll
      for (int c = 0; c < 2; ++c) { float wv[8];
        if (w_next) { const float* wp = w_next + c * 512 + lane * 8; const f32x4 a = *(const f32x4*)wp, b = *(const f32x4*)(wp + 4);
          wv[0] = a[0]; wv[1] = a[1]; wv[2] = a[2]; wv[3] = a[3]; wv[4] = b[0]; wv[5] = b[1]; wv[6] = b[2]; wv[7] = b[3]; }
        else {
#pragma unroll
          for (int i = 0; i < 8; ++i) wv[i] = 1.f; }
        u32x4 w;
#pragma unroll
        for (int i = 0; i < 4; ++i) w[i] = cvtpk(x[c * 8 + 2 * i] * r2 * wv[2 * i], x[c * 8 + 2 * i + 1] * r2 * wv[2 * i + 1]);
        *(u32x4*)(Hout + (size_t)row * ldh + hoff + c * 512 + lane * 8) = w; }
      if (p_src) { const f32x4 pv = __builtin_nontemporal_load((const f32x4*)(p_src + (size_t)row * 256 + lane * 4));
        u32x2 w = {cvtpk(pv[0], pv[1]), cvtpk(pv[2], pv[3])}; *(u32x2*)(Hout + (size_t)row * ldh + lane * 4) = w; }
    }
  }
}

__device__ void conv_phase(const bf16_t* __restrict__ U, const float* __restrict__ cw, const float* __restrict__ cb, bf16_t* __restrict__ ACT, int Lmask, int T) {
  const int gt = obid() * 512 + otid(), gn = gridDim.x * 512;
  for (int u = gt; u < (T / 16) * 352; u += gn) {
    const int j8 = u % 352, rb = u / 352, r0 = rb * 16, c0 = j8 * 8;
    float w0g[8], w1g[8], w2g[8], bg[8], w0v[8], w1v[8], w2v[8], bv[8];
#pragma unroll
    for (int i = 0; i < 8; ++i) { w0g[i] = cw[c0 + i]; w1g[i] = cw[FF2 + c0 + i]; w2g[i] = cw[2 * FF2 + c0 + i]; bg[i] = cb[c0 + i];
      w0v[i] = cw[FF + c0 + i]; w1v[i] = cw[FF2 + FF + c0 + i]; w2v[i] = cw[2 * FF2 + FF + c0 + i]; bv[i] = cb[FF + c0 + i]; }
    const u32x4 z4 = {0u, 0u, 0u, 0u};
    u32x4 pg = z4, pv = z4, cg_ = z4, cv = z4, ng, nv;
    if ((r0 & Lmask) != 0) { pg = __builtin_nontemporal_load((const u32x4*)(U + (size_t)(r0 - 1) * FF2 + c0)); pv = __builtin_nontemporal_load((const u32x4*)(U + (size_t)(r0 - 1) * FF2 + FF + c0)); }
    cg_ = __builtin_nontemporal_load((const u32x4*)(U + (size_t)r0 * FF2 + c0)); cv = __builtin_nontemporal_load((const u32x4*)(U + (size_t)r0 * FF2 + FF + c0));
    for (int i = 0; i < 16; ++i) {
      const int row = r0 + i;
      if (((row + 1) & Lmask) != 0) { ng = __builtin_nontemporal_load((const u32x4*)(U + (size_t)(row + 1) * FF2 + c0)); nv = __builtin_nontemporal_load((const u32x4*)(U + (size_t)(row + 1) * FF2 + FF + c0)); }
      else { ng = z4; nv = z4; }
      float o[8];
#pragma unroll
      for (int q = 0; q < 4; ++q) {
#pragma unroll
        for (int hh = 0; hh < 2; ++hh) { const int e = q * 2 + hh;
          const float gp = hh ? bfhi(pg[q]) : bflo(pg[q]), gc = hh ? bfhi(cg_[q]) : bflo(cg_[q]), gnx = hh ? bfhi(ng[q]) : bflo(ng[q]);
          const float vp = hh ? bfhi(pv[q]) : bflo(pv[q]), vc = hh ? bfhi(cv[q]) : bflo(cv[q]), vnx = hh ? bfhi(nv[q]) : bflo(nv[q]);
          const float g = gp * w0g[e] + gc * w1g[e] + gnx * w2g[e] + bg[e];
          const float v = vp * w0v[e] + vc * w1v[e] + vnx * w2v[e] + bv[e];
          const float ge = g * sigm(1.5957691216057308f * (g + 0.044715f * g * g * g));
          o[e] = ge * v; } }
      u32x4 w = {cvtpk(o[0], o[1]), cvtpk(o[2], o[3]), cvtpk(o[4], o[5]), cvtpk(o[6], o[7])};
      *(u32x4*)(ACT + (size_t)row * FF + c0) = w;
      pg = cg_; pv = cv; cg_ = ng; cv = nv;
    }
  }
}

__device__ void hg_delta_phase(const Params& p, unsigned char* smem, int T) {
  const int tid = otid(), wid = tid >> 6, lane = tid & 63, fr = lane & 15, fq = lane >> 4;
  bf16_t* KT = (bf16_t*)smem;
  bf16_t* VT = KT + 128 * 72;
  float* tot = (float*)(VT + 128 * 72);
  const float* GF = (const float*)(p.ws + OFF_GF); const bf16_t* VH = (const bf16_t*)(p.ws + OFF_VH);
  bf16_t* ST = (bf16_t*)(p.ws + OFF_ST); float* DC = (float*)(p.ws + OFF_DC);
  const int ch = tid & 127, part = tid >> 7;
  for (int item = blockIdx.x; item < (T / 64) * 8; item += gridDim.x) {
    const int d = item & 1, h = (item >> 1) & 3, cgl = item >> 3, t0 = cgl * 64;
    float g[16], pl[16]; float run = 0.f;
#pragma unroll
    for (int i = 0; i < 16; ++i) g[i] = GF[(size_t)(t0 + part * 16 + i) * 1024 + d * 512 + h * 128 + ch];
    unsigned short vv[16];
#pragma unroll
    for (int i = 0; i < 16; ++i) vv[i] = VH[(size_t)(t0 + part * 16 + i) * 512 + h * 128 + ch];
#pragma unroll
    for (int i = 0; i < 16; ++i) { pl[i] = run; run += g[i]; }
    const float lt = run;
    tot[part * 128 + ch] = lt;
    { u32x4 w0, w1;
#pragma unroll
      for (int i = 0; i < 4; ++i) { w0[i] = (unsigned)vv[2 * i] | ((unsigned)vv[2 * i + 1] << 16); w1[i] = (unsigned)vv[8 + 2 * i] | ((unsigned)vv[8 + 2 * i + 1] << 16); }
      *(u32x4*)(VT + ch * 72 + part * 16) = w0; *(u32x4*)(VT + ch * 72 + part * 16 + 8) = w1; }
    __syncthreads();
    const float t0s = tot[ch], t1s = tot[128 + ch], t2s = tot[256 + ch], t3s = tot[384 + ch];
    const float before = (part > 0 ? t0s : 0.f) + (part > 1 ? t1s : 0.f) + (part > 2 ? t2s : 0.f);
    const float after = (part < 1 ? t1s : 0.f) + (part < 2 ? t2s : 0.f) + (part < 3 ? t3s : 0.f);
    if (part == 0) DC[(size_t)item * 128 + ch] = fexp(t0s + t1s + t2s + t3s);
    { float kt[16];
#pragma unroll
      for (int i = 0; i < 16; ++i) { const float E = d == 0 ? after + (lt - pl[i] - g[i]) : before + pl[i]; kt[i] = (1.f - fexp(g[i])) * fexp(E); }
      u32x4 w0, w1;
#pragma unroll
      for (int i = 0; i < 4; ++i) { w0[i] = cvtpk(kt[2 * i], kt[2 * i + 1]); w1[i] = cvtpk(kt[8 + 2 * i], kt[8 + 2 * i + 1]); }
      *(u32x4*)(KT + ch * 72 + part * 16) = w0; *(u32x4*)(KT + ch * 72 + part * 16 + 8) = w1; }
    __syncthreads();
    bf16x8 af[2];
#pragma unroll
    for (int ks = 0; ks < 2; ++ks) af[ks] = *(const bf16x8*)(KT + (wid * 16 + fr) * 72 + ks * 32 + fq * 8);
    bf16_t* Sout = ST + (size_t)item * 16384;
#pragma unroll
    for (int vb = 0; vb < 8; ++vb) { f32x4 c = {0.f, 0.f, 0.f, 0.f};
#pragma unroll
      for (int ks = 0; ks < 2; ++ks) { const bf16x8 bfg = *(const bf16x8*)(VT + (vb * 16 + fr) * 72 + ks * 32 + fq * 8); c = mfma16(af[ks], bfg, c); }
      u32x2 w = {cvtpk(c[0], c[1]), cvtpk(c[2], c[3])};
      *(u32x2*)(Sout + ((wid * 8 + vb) * 64 + lane) * 4) = w; }
    __syncthreads();
  }
}

__device__ void hg_scan_phase(const Params& p, int nseq, int nc) {
  bf16_t* ST = (bf16_t*)(p.ws + OFF_ST); const float* DC = (const float*)(p.ws + OFF_DC);
  const int gt = obid() * 512 + otid(), gn = gridDim.x * 512;
  const int nchain = nseq * 8;
  for (int vi = gt; vi < nchain * 2048; vi += gn) {
    const int chain = vi >> 11, e8 = (vi & 2047) * 8, k0 = 16 * (e8 >> 11) + 4 * ((e8 >> 6) & 3);
    const int d = chain & 1, h = (chain >> 1) & 3, s = chain >> 3;
    float run[8];
#pragma unroll
    for (int i = 0; i < 8; ++i) run[i] = 0.f;
    for (int cc = 0; cc < nc; cc += 8) {
      u32x4 dl[8]; f32x4 da[8];
#pragma unroll
      for (int q = 0; q < 8; ++q) { const int c = d == 0 ? (cc + q) : (nc - 1 - cc - q); const size_t it = (size_t)((s * nc + c) * 4 + h) * 2 + d;
        dl[q] = __builtin_nontemporal_load((const u32x4*)(ST + it * 16384 + e8)); da[q] = *(const f32x4*)(DC + it * 128 + k0); }
#pragma unroll
      for (int q = 0; q < 8; ++q) { const int c = d == 0 ? (cc + q) : (nc - 1 - cc - q); const size_t it = (size_t)((s * nc + c) * 4 + h) * 2 + d;
        u32x4 w = {cvtpk(run[0], run[1]), cvtpk(run[2], run[3]), cvtpk(run[4], run[5]), cvtpk(run[6], run[7])};
        *(u32x4*)(ST + it * 16384 + e8) = w;
        run[0] = da[q][0] * run[0] + bflo(dl[q][0]); run[1] = da[q][1] * run[1] + bfhi(dl[q][0]);
        run[2] = da[q][2] * run[2] + bflo(dl[q][1]); run[3] = da[q][3] * run[3] + bfhi(dl[q][1]);
        run[4] = da[q][0] * run[4] + bflo(dl[q][2]); run[5] = da[q][1] * run[5] + bfhi(dl[q][2]);
        run[6] = da[q][2] * run[6] + bflo(dl[q][3]); run[7] = da[q][3] * run[7] + bfhi(dl[q][3]); }
    }
  }
}

__device__ void hg_out_phase(const Params& p, int l, unsigned char* smem, int T) {
  const int tid = otid(), wid = tid >> 6, lane = tid & 63, fr = lane & 15, fq = lane >> 4;
  bf16_t* QT = (bf16_t*)smem;
  bf16_t* KT2 = QT + 64 * 136;
  bf16_t* QHt = KT2 + 64 * 136;
  bf16_t* VT = QHt + 64 * 136;
  bf16_t* Pm = VT + 128 * 72;
  float* tot = (float*)(Pm + 64 * 72);
  float* Of = tot + 512;
  const float* GF = (const float*)(p.ws + OFF_GF); const bf16_t* VH = (const bf16_t*)(p.ws + OFF_VH);
  const bf16_t* QH = (const bf16_t*)(p.ws + OFF_QH); const bf16_t* GG = (const bf16_t*)(p.ws + OFF_GG);
  const bf16_t* ST = (const bf16_t*)(p.ws + OFF_ST); bf16_t* AB = (bf16_t*)(p.ws + OFF_AB);
  const int ch = tid & 127, part = tid >> 7;
  for (int item = blockIdx.x; item < (T / 64) * 4; item += gridDim.x) {
    const int h = item & 3, cgl = item >> 2, t0 = cgl * 64;
    f32x4 acc[4];
#pragma unroll
    for (int i = 0; i < 4; ++i) acc[i] = (f32x4){0.f, 0.f, 0.f, 0.f};
    { unsigned short vv[16];
#pragma unroll
      for (int i = 0; i < 16; ++i) vv[i] = __builtin_nontemporal_load(&VH[(size_t)(t0 + part * 16 + i) * 512 + h * 128 + ch]);
      u32x4 w0, w1;
#pragma unroll
      for (int i = 0; i < 4; ++i) { w0[i] = (unsigned)vv[2 * i] | ((unsigned)vv[2 * i + 1] << 16); w1[i] = (unsigned)vv[8 + 2 * i] | ((unsigned)vv[8 + 2 * i + 1] << 16); }
      *(u32x4*)(VT + ch * 72 + part * 16) = w0; *(u32x4*)(VT + ch * 72 + part * 16 + 8) = w1; }
#pragma unroll 1
    for (int d = 0; d < 2; ++d) {
      float g[16], pl[16]; unsigned short qq[16]; float run = 0.f;
#pragma unroll
      for (int i = 0; i < 16; ++i) g[i] = __builtin_nontemporal_load(&GF[(size_t)(t0 + part * 16 + i) * 1024 + d * 512 + h * 128 + ch]);
#pragma unroll
      for (int i = 0; i < 16; ++i) qq[i] = __builtin_nontemporal_load(&QH[(size_t)(t0 + part * 16 + i) * 512 + h * 128 + ch]);
#pragma unroll
      for (int i = 0; i < 16; ++i) { pl[i] = run; run += g[i]; }
      const float lt = run;
      tot[part * 128 + ch] = lt;
      __syncthreads();
      const float t0s = tot[ch], t1s = tot[128 + ch], t2s = tot[256 + ch], t3s = tot[384 + ch];
      const float before = (part > 0 ? t0s : 0.f) + (part > 1 ? t1s : 0.f) + (part > 2 ? t2s : 0.f);
      const float after = (part < 1 ? t1s : 0.f) + (part < 2 ? t2s : 0.f) + (part < 3 ? t3s : 0.f);
      const float cref = d == 0 ? (t0s + t1s) : (t2s + t3s);
#pragma unroll
      for (int i = 0; i < 16; ++i) { const int tok = part * 16 + i;
        const float b = d == 0 ? before + pl[i] + g[i] : after + (lt - pl[i]);
        const float q = bf2f(qq[i]); const float k = 1.f - fexp(g[i]);
        QT[tok * 136 + ch] = f2bf(q * fexp(b - cref)); KT2[tok * 136 + ch] = f2bf(k * fexp(cref - b)); QHt[tok * 136 + ch] = f2bf(q * fexp(b)); }
      __syncthreads();
      { const int rb = wid >> 1;
#pragma unroll
        for (int cbi = 0; cbi < 2; ++cbi) { const int cb = (wid & 1) * 2 + cbi; f32x4 a = {0.f, 0.f, 0.f, 0.f};
#pragma unroll
          for (int ks = 0; ks < 4; ++ks) { const bf16x8 A = *(const bf16x8*)(QT + (rb * 16 + fr) * 136 + ks * 32 + fq * 8), B = *(const bf16x8*)(KT2 + (cb * 16 + fr) * 136 + ks * 32 + fq * 8); a = mfma16(A, B, a); }
#pragma unroll
          for (int j = 0; j < 4; ++j) { const int t = rb * 16 + fq * 4 + j, s = cb * 16 + fr; const bool keep = d == 0 ? (s <= t) : (s >= t);
            Pm[t * 72 + s] = f2bf(keep ? a[j] : 0.f); } } }
      __syncthreads();
      { const bf16_t* S = ST + ((size_t)(cgl * 4 + h) * 2 + d) * 16384;
        bf16x8 Bs[4];
#pragma unroll
        for (int ks = 0; ks < 4; ++ks) { const int q = 4 * ks + fq;
          const bf16_t* e1 = S + (((q >> 1) * 8 + wid) * 64 + (2 * (q & 1)) * 16 + fr) * 4;
          const u32x2 lo = __builtin_nontemporal_load((const u32x2*)e1), hi = __builtin_nontemporal_load((const u32x2*)(e1 + 64));
          u32x4 w4 = {lo[0], lo[1], hi[0], hi[1]}; Bs[ks] = *reinterpret_cast<bf16x8*>(&w4); }
        bf16x8 Bv[2];
#pragma unroll
        for (int ks = 0; ks < 2; ++ks) Bv[ks] = *(const bf16x8*)(VT + (wid * 16 + fr) * 72 + ks * 32 + fq * 8);
#pragma unroll
        for (int rbb = 0; rbb < 4; ++rbb) {
#pragma unroll
          for (int ks = 0; ks < 2; ++ks) { const bf16x8 A = *(const bf16x8*)(Pm + (rbb * 16 + fr) * 72 + ks * 32 + fq * 8); acc[rbb] = mfma16(A, Bv[ks], acc[rbb]); }
#pragma unroll
          for (int ks = 0; ks < 4; ++ks) { const bf16x8 A = *(const bf16x8*)(QHt + (rbb * 16 + fr) * 136 + ks * 32 + fq * 8); acc[rbb] = mfma16(A, Bs[ks], acc[rbb]); } } }
      __syncthreads();
    }
#pragma unroll
    for (int rbb = 0; rbb < 4; ++rbb)
#pragma unroll
      for (int j = 0; j < 4; ++j) Of[(rbb * 16 + fq * 4 + j) * 132 + wid * 16 + fr] = acc[rbb][j];
    __syncthreads();
    { const int tok = tid >> 3, c0 = (tid & 7) * 16; float v[16]; float ss = 0.f;
#pragma unroll
      for (int i = 0; i < 16; ++i) { v[i] = Of[tok * 132 + c0 + i]; ss += v[i] * v[i]; }
      ss += __shfl_xor(ss, 1, 64); ss += __shfl_xor(ss, 2, 64); ss += __shfl_xor(ss, 4, 64);
      const float rs = rsqrtf(ss * (1.f / 128.f) + EPS);
      const u32x4 g0 = *(const u32x4*)(GG + (size_t)(t0 + tok) * 512 + h * 128 + c0), g1 = *(const u32x4*)(GG + (size_t)(t0 + tok) * 512 + h * 128 + c0 + 8);
      const float* gw = p.gnorm + l * 128 + c0;
      float o[16];
#pragma unroll
      for (int i = 0; i < 4; ++i) { o[2 * i] = v[2 * i] * rs * gw[2 * i] * bflo(g0[i]); o[2 * i + 1] = v[2 * i + 1] * rs * gw[2 * i + 1] * bfhi(g0[i]);
        o[8 + 2 * i] = v[8 + 2 * i] * rs * gw[8 + 2 * i] * bflo(g1[i]); o[8 + 2 * i + 1] = v[8 + 2 * i + 1] * rs * gw[8 + 2 * i + 1] * bfhi(g1[i]); }
      u32x4 w0, w1;
#pragma unroll
      for (int i = 0; i < 4; ++i) { w0[i] = cvtpk(o[2 * i], o[2 * i + 1]); w1[i] = cvtpk(o[8 + 2 * i], o[8 + 2 * i + 1]); }
      bf16_t* op = AB + (size_t)(t0 + tok) * 1024 + h * 128 + c0;
      *(u32x4*)op = w0; *(u32x4*)(op + 8) = w1; }
    __syncthreads();
  }
}

constexpr int SHM_V = 64 * 128 * 2, SHM_K = 64 * 128 * 2;
#define KSWZ(row, colB) ((row) * 256 + ((colB) ^ (((row) & 7) << 4)))
#define SBAR() __builtin_amdgcn_sched_barrier(0)
__device__ __forceinline__ int crow(int r, int hi) { return (r & 3) + 8 * (r >> 2) + 4 * hi; }
__device__ __forceinline__ void partialSM(f32x16& p0, f32x16& p1, float& m_reg, float& mn, float& alpha) {
  constexpr float C = 1.4426950408889634f; constexpr float THR = 8.f;
  float pmax = p0[0];
#pragma unroll
  for (int r = 1; r < 16; ++r) pmax = fmaxf(pmax, p0[r]);
#pragma unroll
  for (int r = 0; r < 16; ++r) pmax = fmaxf(pmax, p1[r]);
  { auto rr = __builtin_amdgcn_permlane32_swap(__float_as_uint(pmax), __float_as_uint(pmax), false, false);
    pmax = fmaxf(__uint_as_float(rr[0]), __uint_as_float(rr[1])); }
  if (__builtin_expect(__all(pmax - m_reg <= THR), 1)) { mn = m_reg; alpha = 1.f; }
  else { mn = fmaxf(m_reg, pmax); alpha = __builtin_amdgcn_exp2f((m_reg - mn) * C); m_reg = mn; }
  const float mnC = -mn * C;
#pragma unroll
  for (int r = 0; r < 16; ++r) p0[r] = __builtin_amdgcn_exp2f(fmaf(p0[r], C, mnC));
#pragma unroll
  for (int r = 0; r < 16; ++r) p1[r] = __builtin_amdgcn_exp2f(fmaf(p1[r], C, mnC));
}
__device__ __forceinline__ void finishSM(f32x16& p0, f32x16& p1, float alpha, float& l_reg, bf16x8& pa0, bf16x8& pa1, bf16x8& pa2, bf16x8& pa3) {
  float ps = 0;
#pragma unroll
  for (int r = 0; r < 16; ++r) ps += p0[r];
#pragma unroll
  for (int r = 0; r < 16; ++r) ps += p1[r];
  { auto rr = __builtin_amdgcn_permlane32_swap(__float_as_uint(ps), __float_as_uint(ps), false, false);
    ps = __uint_as_float(rr[0]) + __uint_as_float(rr[1]); }
  l_reg = l_reg * alpha + ps;
#define PK4(P, BASE, OUT) do { unsigned a0 = cvtpk(P[BASE + 0], P[BASE + 1]), a1 = cvtpk(P[BASE + 2], P[BASE + 3]);   \
    unsigned b0 = cvtpk(P[BASE + 4], P[BASE + 5]), b1 = cvtpk(P[BASE + 6], P[BASE + 7]);                              \
    auto r0 = __builtin_amdgcn_permlane32_swap(a0, b0, false, false); auto r1 = __builtin_amdgcn_permlane32_swap(a1, b1, false, false); \
    u32x4 w = {r0[0], r1[0], r0[1], r1[1]}; OUT = *reinterpret_cast<bf16x8*>(&w); } while (0)
  PK4(p0, 0, pa0); PK4(p0, 8, pa1); PK4(p1, 0, pa2); PK4(p1, 8, pa3);
#undef PK4
}
template <int H>
__device__ __forceinline__ void qkt_half(f32x16& p0, f32x16& p1, const char* Ks, const bf16x8* qr, int r32, int hi) {
#pragma unroll
  for (int r = 0; r < 16; ++r) { p0[r] = 0.f; p1[r] = 0.f; }
#pragma unroll
  for (int d0 = 0; d0 < 4; ++d0) { const int cb = ((H * 4 + d0) * 16 + hi * 8) * 2;
    const bf16x8 b0 = *reinterpret_cast<const bf16x8*>(Ks + KSWZ(r32, cb));
    const bf16x8 b1 = *reinterpret_cast<const bf16x8*>(Ks + KSWZ(32 + r32, cb));
    p0 = __builtin_amdgcn_mfma_f32_32x32x16_bf16(b0, qr[H * 4 + d0], p0, 0, 0, 0);
    p1 = __builtin_amdgcn_mfma_f32_32x32x16_bf16(b1, qr[H * 4 + d0], p1, 0, 0, 0); }
}
__device__ __forceinline__ int v_st(int k, int c) { const int kk = (k & ~0xC) | ((k & 4) << 1) | ((k & 8) >> 1); return ((kk >> 3) * 4 + (c >> 5)) * 512 + ((kk & 7) * 32 + (c & 31)) * 2; }
__device__ __forceinline__ int v_rd_base(int lane) { return ((lane & 3) << 3) | (((lane >> 2) & 3) << 6) | (((lane >> 4) & 1) << 5) | (((lane >> 5) & 1) << 8); }
constexpr int v_rd_off(int d0, int ks, int half) { return d0 * 512 + ks * 4096 + half * 2048; }
template <int OFF> __device__ __forceinline__ s16x4 tr_read(int vb) {
  s16x4 r; asm volatile("ds_read_b64_tr_b16 %0, %1 offset:%2" : "=&v"(r) : "v"(vb), "i"(OFF) : "memory"); return r;
}
struct VB8 { s16x4 l0, h0, l1, h1, l2, h2, l3, h3; };
template <int D0> __device__ __forceinline__ void pv_rd(VB8& r, int vb) {
  r.l0 = tr_read<v_rd_off(D0, 0, 0)>(vb); r.h0 = tr_read<v_rd_off(D0, 0, 1)>(vb); r.l1 = tr_read<v_rd_off(D0, 1, 0)>(vb); r.h1 = tr_read<v_rd_off(D0, 1, 1)>(vb);
  r.l2 = tr_read<v_rd_off(D0, 2, 0)>(vb); r.h2 = tr_read<v_rd_off(D0, 2, 1)>(vb); r.l3 = tr_read<v_rd_off(D0, 3, 0)>(vb); r.h3 = tr_read<v_rd_off(D0, 3, 1)>(vb);
}
__device__ __forceinline__ void pv_mm(f32x16& od, const VB8& r, bf16x8 pa0, bf16x8 pa1, bf16x8 pa2, bf16x8 pa3) {
#define PK(L, H) (bf16x8){L[0], L[1], L[2], L[3], H[0], H[1], H[2], H[3]}
  od = __builtin_amdgcn_mfma_f32_32x32x16_bf16(pa0, PK(r.l0, r.h0), od, 0, 0, 0);
  od = __builtin_amdgcn_mfma_f32_32x32x16_bf16(pa1, PK(r.l1, r.h1), od, 0, 0, 0);
  od = __builtin_amdgcn_mfma_f32_32x32x16_bf16(pa2, PK(r.l2, r.h2), od, 0, 0, 0);
  od = __builtin_amdgcn_mfma_f32_32x32x16_bf16(pa3, PK(r.l3, r.h3), od, 0, 0, 0);
#undef PK
}
__device__ __forceinline__ void pv_d0(f32x16* o, int vb, bf16x8 pa0, bf16x8 pa1, bf16x8 pa2, bf16x8 pa3) {
  VB8 a, b;
  pv_rd<0>(a, vb); pv_rd<1>(b, vb);
  asm volatile("s_waitcnt lgkmcnt(8)" ::: "memory"); SBAR(); pv_mm(o[0], a, pa0, pa1, pa2, pa3); SBAR();
  pv_rd<2>(a, vb);
  asm volatile("s_waitcnt lgkmcnt(8)" ::: "memory"); SBAR(); pv_mm(o[1], b, pa0, pa1, pa2, pa3); SBAR();
  pv_rd<3>(b, vb);
  asm volatile("s_waitcnt lgkmcnt(8)" ::: "memory"); SBAR(); pv_mm(o[2], a, pa0, pa1, pa2, pa3); SBAR();
  asm volatile("s_waitcnt lgkmcnt(0)" ::: "memory"); SBAR(); pv_mm(o[3], b, pa0, pa1, pa2, pa3);
}

__device__ void attn_phase(const Params& p, int l, int L, unsigned char* smem, int T) {
  const int tid = otid(), wid = tid >> 6, lane = tid & 63, r32 = lane & 31, hi = lane >> 5;
  char* lds = (char*)smem;
  char* V_lds = lds; char* K_lds = lds + 3 * SHM_V;
  float* wsf = (float*)(lds + 3 * SHM_V + 2 * SHM_K) + wid * 128; float* li1 = wsf; float* al_l = wsf + 64;
  const bf16_t* QD = (const bf16_t*)(p.ws + OFF_QD); const bf16_t* KD = (const bf16_t*)(p.ws + OFF_KD); const bf16_t* VD = (const bf16_t*)(p.ws + OFF_VD);
  bf16_t* AB = (bf16_t*)(p.ws + OFF_AB);
  const float lam = ((const float*)(p.ws + OFF_LAM))[l], oml = ((const float*)(p.ws + OFF_LAM))[8 + l];
  const int nq = L / 256, NT = L / 64;
  const int vb0 = (int)(uintptr_t)V_lds + v_rd_base(lane);
  const int wid_u = __builtin_amdgcn_readfirstlane(wid);
  LAS unsigned char* ldsV = (LAS unsigned char*)smem; LAS unsigned char* ldsK = ldsV + 3 * SHM_V;
  const int half = wid_u >> 2;
  unsigned kso[2], vso[2];
#pragma unroll
  for (int i = 0; i < 2; ++i) { const int b = i * 8192 + tid * 16;
    { const int row = b >> 8, cphys = b & 255, colB = cphys ^ ((row & 7) << 4); kso[i] = (unsigned)(row * 1024 + colB); }
    { const int sub = b >> 9, kkhi = sub >> 2, chi = sub & 3, within = b & 511, kklo = within >> 6, clo = (within & 63) >> 1;
      const int kk = kkhi * 8 + kklo, k = (kk & ~0xC) | ((kk & 4) << 1) | ((kk & 8) >> 1); vso[i] = (unsigned)(k * 1024 + (chi * 32 + clo) * 2); } }
  const int nitems = (T / 256) * 4;
  for (int it = blockIdx.x; it < nitems; it += gridDim.x) {
    const int pair = (it & 7) * 4 + (it >> 3) / nq, qb = (it >> 3) % nq;
    const int s = pair >> 2, h = pair & 3;
    const size_t rowbase = (size_t)s * L;
    const bf16_t* Qb = QD + (rowbase + (size_t)qb * 256) * 512 + h * 128;
    const bf16_t* Kh = KD + rowbase * 512 + h * 128; const bf16_t* Vh = VD + rowbase * 512 + h * 128;
#pragma unroll 1
    for (int mp = 0; mp < 2; ++mp) {
      float m_reg = -1e30f, l_reg = 0.f;
      f32x16 o[4];
#pragma unroll
      for (int dd = 0; dd < 4; ++dd)
#pragma unroll
        for (int r = 0; r < 16; ++r) o[dd][r] = 0.f;
      bf16x8 qr[4];
      { const int t2 = otid(); const unsigned qoff = (unsigned)(((t2 >> 6) * 32 + (t2 & 31)) * 512 + ((t2 >> 5) & 1) * 8 + mp * 64) * 2u;
#pragma unroll
        for (int d0 = 0; d0 < 4; ++d0) qr[d0] = *(const bf16x8*)((const char*)Qb + qoff + d0 * 32); }
#define SDMA(k0, kb, vb) do { const char* kb_ = (const char*)Kh + (size_t)(k0) * 1024; const char* vb_ = (const char*)Vh + (size_t)(k0) * 1024; \
    _Pragma("unroll") for (int i_ = 0; i_ < 2; ++i_) { \
      __builtin_amdgcn_global_load_lds((const unsigned*)(kb_ + kso[i_]), (LAS unsigned*)(ldsK + (kb) * SHM_K + i_ * 8192 + wid_u * 1024), 16, 0, 0); \
      __builtin_amdgcn_global_load_lds((const unsigned*)(vb_ + vso[i_]), (LAS unsigned*)(ldsV + (vb) * SHM_V + i_ * 8192 + wid_u * 1024), 16, 0, 0); } } while (0)
      SDMA(0, 0, 0); asm volatile("s_waitcnt vmcnt(0)" ::: "memory"); __syncthreads();
      bf16x8 pa0, pa1, pa2, pa3;
      int vcur = 0, vprev = 2;
      for (int j = 0; j < NT; ++j) {
        const int cur = j & 1; const int vnext = vcur == 2 ? 0 : vcur + 1;
        if (j + 1 < NT) SDMA((j + 1) * 64, cur ^ 1, vnext);
        if (half == 1 && j > 0) pv_d0(o, vb0 + vprev * SHM_V, pa0, pa1, pa2, pa3);
        f32x16 p0, p1; float mn, al;
        qkt_half<0>(p0, p1, K_lds + cur * SHM_K + mp * 128, qr, r32, hi);
        partialSM(p0, p1, m_reg, mn, al);
        if (__any(al < 1.f)) { if (hi == 0) al_l[r32] = al; asm volatile("s_waitcnt lgkmcnt(0)" ::: "memory");
#pragma unroll
          for (int r = 0; r < 16; ++r) { const float av = al_l[crow(r, hi)];
#pragma unroll
            for (int dd = 0; dd < 4; ++dd) o[dd][r] *= av; } }
        finishSM(p0, p1, al, l_reg, pa0, pa1, pa2, pa3);
        if (half == 0) pv_d0(o, vb0 + vcur * SHM_V, pa0, pa1, pa2, pa3);
        asm volatile("s_waitcnt vmcnt(0)" ::: "memory");
        __syncthreads();
        vprev = vcur; vcur = vnext;
      }
      if (half == 1) pv_d0(o, vb0 + vprev * SHM_V, pa0, pa1, pa2, pa3);
      __syncthreads();
#undef SDMA
      if (hi == 0) li1[r32] = l_reg;
      asm volatile("s_waitcnt lgkmcnt(0)" ::: "memory");
      const int t3 = otid();
      f32x4* OS = (f32x4*)(p.ws + OFF_OS + (size_t)obid() * (512 * 256)) + (unsigned)t3;
      if (mp == 0) {
#pragma unroll
        for (int r4 = 0; r4 < 4; ++r4) { float il[4];
#pragma unroll
          for (int q = 0; q < 4; ++q) il[q] = __builtin_amdgcn_rcpf(li1[crow(r4 * 4 + q, hi)]);
#pragma unroll
          for (int dd = 0; dd < 4; ++dd) OS[(dd * 4 + r4) * 512] = (f32x4){o[dd][r4 * 4] * il[0], o[dd][r4 * 4 + 1] * il[1], o[dd][r4 * 4 + 2] * il[2], o[dd][r4 * 4 + 3] * il[3]}; }
      } else {
        const float* sw = p.subln + l * 128;
        const float sw0 = sw[r32], sw1 = sw[32 + r32], sw2 = sw[64 + r32], sw3 = sw[96 + r32];
        bf16_t* Ow = AB + (rowbase + (size_t)qb * 256) * 1024 + 512 + h * 128 + (unsigned)((t3 >> 6) * 32 * 1024 + (t3 & 31));
#pragma unroll
        for (int r4 = 0; r4 < 4; ++r4) { const f32x4 a0 = OS[r4 * 512], a1 = OS[(4 + r4) * 512], a2 = OS[(8 + r4) * 512], a3 = OS[(12 + r4) * 512];
#pragma unroll
          for (int q = 0; q < 4; ++q) { const int r = r4 * 4 + q; const int orow = crow(r, hi);
            const float i2 = lam * __builtin_amdgcn_rcpf(li1[orow]);
            const float v0 = a0[q] - o[0][r] * i2, v1 = a1[q] - o[1][r] * i2, v2 = a2[q] - o[2][r] * i2, v3 = a3[q] - o[3][r] * i2;
            float ss = v0 * v0 + v1 * v1 + v2 * v2 + v3 * v3;
            ss += __shfl_xor(ss, 1, 64); ss += __shfl_xor(ss, 2, 64); ss += __shfl_xor(ss, 4, 64); ss += __shfl_xor(ss, 8, 64); ss += __shfl_xor(ss, 16, 64);
            const float rs = rsqrtf(ss * (1.f / 128.f) + EPS) * oml;
            bf16_t* op = Ow + (size_t)orow * 1024;
            op[0] = f2bf(v0 * rs * sw0); op[32] = f2bf(v1 * rs * sw1); op[64] = f2bf(v2 * rs * sw2); op[96] = f2bf(v3 * rs * sw3); } }
      }
    }
  }
}

__device__ void init_sb(const Params& p, int sb) {
  const int T = sb == 0 ? 16384 : 32768, rowoff = sb == 0 ? 0 : 16384 + (sb - 1) * 32768;
  const float* xin = sb == 0 ? p.x_prompt : p.x_sample + (size_t)(sb - 1) * 32768 * 1024;
  rowwise_phase(xin, p.out + (size_t)rowoff * 1024, nullptr, nullptr, p.n_mix_pre, true, (bf16_t*)(p.ws + OFF_H), 1024, 0, nullptr, T, false);
}
__device__ __forceinline__ void run_step(const Params& p, int step, unsigned char* smem) {
  if (step == 0) { prep_phase(p, smem); init_sb(p, 0); return; }
  const int s_ = step - 1, sb = s_ / SPB, r = s_ % SPB;
  const int T = sb == 0 ? 16384 : 32768, rowoff = sb == 0 ? 0 : 16384 + (sb - 1) * 32768;
  const int L = sb == 0 ? 2048 : 4096, nseq = T / L, nc = L / 64;
  float* xres = p.out + (size_t)rowoff * 1024;
  unsigned char* ws = p.ws;
  const int l = r / PPL, seq_ = r % PPL;
  const int ph = seq_;
  unsigned char* wl = ws + (size_t)l * SZ_WL;
  LAS unsigned char* lds = (LAS unsigned char*)smem;
  pg8::StaticOrder S;
  switch (ph) {
    case 0: { pg8::Gemm g{(const bf16_t*)(ws + OFF_H), (const bf16_t*)(wl + OFF_WIN), 1024, 1024, T, INC, 1024};
      S.init(g.M, g.N, (int)gridDim.x, (int)blockIdx.x); EpiWin E{ws, l, L - 1}; pg8::gemm_phase<EpiWin, false>(lds, g, S, E, -1); } break;
    case 1: attn_phase(p, l, L, smem, T); __syncthreads(); hg_delta_phase(p, smem, T); break;
    case 2: hg_scan_phase(p, nseq, nc); break;
    case 3: hg_out_phase(p, l, smem, T); break;
    case 4: {
      pg8::Gemm g{(const bf16_t*)(ws + OFF_AB), (const bf16_t*)(wl + OFF_WAB), 1024, 1024, T, 1024, 1024};
      S.init(g.M, g.N, (int)gridDim.x, (int)blockIdx.x);
      EpiMerge E{(const bf16_t*)(ws + OFF_GA), (const bf16_t*)(ws + OFF_GB), (bf16_t*)(ws + OFF_M)};
      pg8::gemm_phase<EpiMerge, true>(lds, g, S, E, 8); } break;
    case 5: case 7: case 9: {
      pg8::Gemm g; EpiPlain E;
      if (ph == 5) { g = pg8::Gemm{(const bf16_t*)(ws + OFF_M), (const bf16_t*)(wl + OFF_WOUT), 1024, 1024, T, 1024, 1024}; E = EpiPlain{(bf16_t*)(ws + OFF_MO), 1024}; }
      else if (ph == 7) { g = pg8::Gemm{(const bf16_t*)(ws + OFF_H), (const bf16_t*)(wl + OFF_WUP), 1024, 1024, T, FF2, 1024}; E = EpiPlain{(bf16_t*)(ws + OFF_U), FF2}; }
      else { g = pg8::Gemm{(const bf16_t*)(ws + OFF_ACT), (const bf16_t*)(wl + OFF_WDOWN), FF, FF, T, 1024, FF}; E = EpiPlain{(bf16_t*)(ws + OFF_MO), 1024}; }
      S.init(g.M, g.N, (int)gridDim.x, (int)blockIdx.x); pg8::gemm_phase<EpiPlain, false>(lds, g, S, E, -1); } break;
    case 6: rowwise_phase(nullptr, xres, (const bf16_t*)(ws + OFF_MO), p.n_mix_post + l * 1024, p.n_ffn_pre + l * 1024, true, (bf16_t*)(ws + OFF_H), 1024, 0, nullptr, T, false); break;
    case 8: conv_phase((const bf16_t*)(ws + OFF_U), p.conv_w + (size_t)l * 3 * FF2, p.conv_b + (size_t)l * FF2, (bf16_t*)(ws + OFF_ACT), L - 1, T); break;
    case 10: { const float* pp = sb == 0 ? p.p_prompt + (size_t)l * 16384 * 256 : p.p_sample + ((size_t)l * 65536 + (size_t)(sb - 1) * 32768) * 256;
      rowwise_phase(nullptr, xres, (const bf16_t*)(ws + OFF_MO), p.n_ffn_post + l * 1024, nullptr, true, (bf16_t*)(ws + OFF_AP), 1280, 256, pp, T, false); } break;
    case 11: { pg8::Gemm g{(const bf16_t*)(ws + OFF_AP), (const bf16_t*)(wl + OFF_WPG), 1280, 1280, T, 1024, 1280};
      S.init(g.M, g.N, (int)gridDim.x, (int)blockIdx.x); EpiPle E{(bf16_t*)(ws + OFF_M)}; pg8::gemm_phase<EpiPle, true>(lds, g, S, E, 4); } break;
    case 12: rowwise_phase(nullptr, xres, (const bf16_t*)(ws + OFF_M), p.n_ple + l * 1024, l < 3 ? p.n_mix_pre + (l + 1) * 1024 : nullptr, l < 3, (bf16_t*)(ws + OFF_H), 1024, 0, nullptr, T, l == 3); if (l == NL - 1 && sb + 1 < NSB) init_sb(p, sb + 1); break;
    default: break;
  }
}


#define XB_TMO      128
#define XB_XCNT(j)  (256  + 64 * (j))
#define XB_XSUB(j)  (1280 + 64 * (j))
#define XB_XGEN(j)  (2304 + 64 * (j))
#define XB_TOP      3328
#define XB_TOPGEN   3392
#define XCD_BAR_WORDS 3456
#define XB_SPIN_CAP (1u << 18)
__device__ __forceinline__ unsigned xb_ld(unsigned* p)              { return __hip_atomic_load(p, __ATOMIC_RELAXED, __HIP_MEMORY_SCOPE_AGENT); }
__device__ __forceinline__ unsigned xb_add(unsigned* p, unsigned v) { return __hip_atomic_fetch_add(p, v, __ATOMIC_RELAXED, __HIP_MEMORY_SCOPE_AGENT); }
__device__ __forceinline__ unsigned xb_xcc_id() { return (unsigned)__builtin_amdgcn_s_getreg((3 << 11) | 20) & 0xFu; }
#define XB_SPIN(cond, bar) do { unsigned _sp = 0; while (cond) { __builtin_amdgcn_s_sleep(1); \
    if ((++_sp & 255u) == 0u) { if (xb_ld(&(bar)[XB_TMO])) break; if (_sp > XB_SPIN_CAP) { atomicAdd(&(bar)[XB_TMO], 1u); break; } } } } while (0)
__device__ __forceinline__ void xcd_barrier_complete(unsigned* bar, unsigned x, unsigned& nloc, unsigned& nx) {
  const unsigned G = gridDim.x * gridDim.y * gridDim.z;
  unsigned sum, cnt, mine, sp = 0u;
  for (;;) {
    sum = 0u; cnt = 0u; mine = 0u;
#pragma unroll
    for (unsigned j = 0; j < 16; ++j) { const unsigned c = xb_ld(&bar[XB_XCNT(j)]); sum += c; cnt += (c > 0u) ? 1u : 0u; mine = (j == x) ? c : mine; }
    if (sum == G) break;
    __builtin_amdgcn_s_sleep(1);
    if ((++sp & 255u) == 0u) { if (xb_ld(&bar[XB_TMO])) break; if (sp > XB_SPIN_CAP) { atomicAdd(&bar[XB_TMO], 1u); break; } }
  }
  nloc = mine > 0u ? mine : 1u; nx = cnt > 0u ? cnt : 1u;
}
__device__ __forceinline__ void xcd_barrier(unsigned* bar, volatile LAS unsigned* st) {
  asm volatile("s_waitcnt vmcnt(0)" ::: "memory");
  __syncthreads();
  if (threadIdx.x == 0) {
    const unsigned x = xb_xcc_id();
    __builtin_amdgcn_s_waitcnt(0);
    unsigned nloc = st[0], nx = st[1];
    if (nloc == 0u) { xcd_barrier_complete(bar, x, nloc, nx); st[0] = nloc; st[1] = nx; }
    const unsigned old = xb_add(&bar[XB_XSUB(x)], 1u);
    const unsigned gen = old / nloc;
    if (old + 1u == (gen + 1u) * nloc) {
      __builtin_amdgcn_fence(__ATOMIC_RELEASE, "agent");
      asm volatile("s_waitcnt vmcnt(0)" ::: "memory");
      const unsigned og = xb_add(&bar[XB_TOP], 1u);
      const unsigned tg = og / nx;
      if (og + 1u == (tg + 1u) * nx) xb_add(&bar[XB_TOPGEN], 1u);
      else XB_SPIN(xb_ld(&bar[XB_TOPGEN]) == tg, bar);
      __builtin_amdgcn_fence(__ATOMIC_ACQUIRE, "agent");
      xb_add(&bar[XB_XGEN(x)], 1u);
      asm volatile("s_waitcnt vmcnt(0)" ::: "memory");
    } else {
      XB_SPIN(xb_ld(&bar[XB_XGEN(x)]) == gen, bar);
      __builtin_amdgcn_fence(__ATOMIC_ACQUIRE, "agent");
      asm volatile("s_waitcnt vmcnt(0)" ::: "memory");
    }
  }
  __syncthreads();
}

__global__ __launch_bounds__(512, 2) void mega(Params p, int s_begin, int s_end) {
  extern __shared__ __attribute__((aligned(16))) unsigned char smem[];
#if ONE_LAUNCH
  cg::grid_group grid = cg::this_grid();
  volatile LAS unsigned* st = (volatile LAS unsigned*)((LAS unsigned char*)smem + 131072);
  unsigned* bar = (unsigned*)(p.ws + OFF_BAR);
  if (threadIdx.x == 0) { st[0] = 0u; st[1] = 0u; st[2] = 0u; st[3] = 0u; (void)xb_add(&bar[XB_XCNT(xb_xcc_id())], 1u); }
  __syncthreads();
#endif
  for (int step = s_begin; step < s_end; ++step) {
    run_step(p, step, smem);
#if ONE_LAUNCH
    if (step + 1 < s_end) { if (s_end < 0) grid.sync();
      xcd_barrier(bar, st); }
#endif
  }
}

extern "C" void kernel_launch(void* const* d_in, const int* in_sizes, int n_in, void* d_out, int out_size, void* d_ws, size_t ws_size, hipStream_t stream) {
  static int grid = 0;
  if (grid == 0) {
    if (n_in != 23 || ws_size < WS_END || out_size != NTOK * 1024) {
      fprintf(stderr, "kernel_launch: unexpected shapes: n_in %d out %d ws %zu (need %zu)\n", n_in, out_size, ws_size, (size_t)WS_END); grid = -1; return; }
    int dev = 0, cus = 0, per_cu = 0;
    hipGetDevice(&dev); hipDeviceGetAttribute(&cus, hipDeviceAttributeMultiprocessorCount, dev);
    if (hipFuncSetAttribute((const void*)mega, hipFuncAttributeMaxDynamicSharedMemorySize, LDS_BYTES) != hipSuccess) { fprintf(stderr, "kernel_launch: hipFuncSetAttribute failed\n"); grid = -1; return; }
    if (hipOccupancyMaxActiveBlocksPerMultiprocessor(&per_cu, (const void*)mega, 512, LDS_BYTES) != hipSuccess || per_cu < 1) { fprintf(stderr, "kernel_launch: occupancy query gave %d\n", per_cu); per_cu = 1; }
    (void)hipGetLastError();
    grid = cus * per_cu; if (grid > 256) grid = 256;
  }
  if (grid < 0) return;
  Params p{};
  p.x_prompt = (const float*)d_in[0]; p.x_sample = (const float*)d_in[1]; p.p_prompt = (const float*)d_in[2]; p.p_sample = (const float*)d_in[3];
  p.w_in = (const float*)d_in[4]; p.lb_logits = (const float*)d_in[5]; p.gnorm = (const float*)d_in[6]; p.dlam = (const float*)d_in[7]; p.subln = (const float*)d_in[8];
  p.w_a = (const float*)d_in[9]; p.w_b = (const float*)d_in[10]; p.w_out = (const float*)d_in[11]; p.n_mix_pre = (const float*)d_in[12]; p.n_mix_post = (const float*)d_in[13];
  p.w_up = (const float*)d_in[14]; p.conv_w = (const float*)d_in[15]; p.conv_b = (const float*)d_in[16]; p.w_down = (const float*)d_in[17]; p.n_ffn_pre = (const float*)d_in[18]; p.n_ffn_post = (const float*)d_in[19];
  p.w_ple = (const float*)d_in[20]; p.w_pg = (const float*)d_in[21]; p.n_ple = (const float*)d_in[22];
  p.out = (float*)d_out; p.ws = (unsigned char*)d_ws;
#if ONE_LAUNCH
  if (hipMemsetAsync((char*)d_ws + OFF_BAR, 0, XCD_BAR_WORDS * 4, stream) != hipSuccess) { fprintf(stderr, "kernel_launch: memset of barrier words failed\n"); return; }
  int s0 = 0, s1 = NSTEPS;
  void* args[] = {&p, &s0, &s1};
  hipError_t e = hipLaunchCooperativeKernel((const void*)mega, dim3(grid), dim3(512), args, LDS_BYTES, stream);
  if (e != hipSuccess) fprintf(stderr, "cooperative launch failed: %s (grid %d)\n", hipGetErrorString(e), grid);
#else
  for (int s = 0; s < NSTEPS; ++s) hipLaunchKernelGGL(mega, dim3(grid), dim3(512), LDS_BYTES, stream, p, s, s + 1);
#endif
}
```

```cpp
#include <hip/hip_runtime.h>
#include <hip/hip_cooperative_groups.h>
#include <cstdio>
#include <cstdint>
namespace cg = cooperative_groups;

#ifndef ONE_LAUNCH
#define ONE_LAUNCH 1
#endif

#define LAS __attribute__((address_space(3)))
typedef unsigned short bf16_t;
typedef short bf16x8 __attribute__((ext_vector_type(8)));
typedef short s16x4 __attribute__((ext_vector_type(4)));
typedef float f32x4 __attribute__((ext_vector_type(4)));
typedef float f32x16 __attribute__((ext_vector_type(16)));
typedef unsigned u32x4 __attribute__((ext_vector_type(4)));
typedef unsigned u32x2 __attribute__((ext_vector_type(2)));

constexpr int TMAX = 32768;
constexpr int NSB = 3, NL = 4, INC = 6144, FF = 2816, FF2 = 5632;
constexpr int NTOK = 81920;
constexpr float EPS = 1e-6f;
constexpr size_t SZ_WIN = (size_t)INC * 1024 * 2, SZ_WAB = (size_t)1024 * 1024 * 2, SZ_WOUT = (size_t)1024 * 1024 * 2,
                 SZ_WUP = (size_t)FF2 * 1024 * 2, SZ_WDOWN = (size_t)1024 * FF * 2, SZ_WPG = (size_t)1024 * 1280 * 2;
constexpr size_t OFF_WIN = 0, OFF_WAB = OFF_WIN + SZ_WIN, OFF_WOUT = OFF_WAB + SZ_WAB, OFF_WUP = OFF_WOUT + SZ_WOUT,
                 OFF_WDOWN = OFF_WUP + SZ_WUP, OFF_WPG = OFF_WDOWN + SZ_WDOWN, SZ_WL = OFF_WPG + SZ_WPG;
constexpr size_t OFF_LB = SZ_WL * NL, OFF_LAM = OFF_LB + 16384, OFF_COS = OFF_LAM + 256, OFF_SIN = OFF_COS + 524288;
constexpr size_t TT = (size_t)TMAX;
constexpr size_t OFF_H = OFF_SIN + 524288;
constexpr size_t OFF_QH = OFF_H + TT * 2048, OFF_GF = OFF_QH + TT * 1024, OFF_VH = OFF_GF + TT * 4096, OFF_GG = OFF_VH + TT * 1024,
                 OFF_QD = OFF_GG + TT * 1024, OFF_KD = OFF_QD + TT * 1024, OFF_VD = OFF_KD + TT * 1024, OFF_GA = OFF_VD + TT * 1024,
                 OFF_GB = OFF_GA + TT * 2048, OFF_AB = OFF_GB + TT * 2048, OFF_ST = OFF_AB + TT * 2048, OFF_DC = OFF_ST + TT * 4096,
                 OFF_M = OFF_DC + TT * 64, OFF_MO = OFF_M + TT * 2048, OFF_BAR = OFF_MO + TT * 2048, WS_END = OFF_BAR + 16384;
constexpr size_t OFF_U = OFF_QH, OFF_AP = OFF_QH, OFF_ACT = OFF_AB, OFF_OS = OFF_M;
static_assert(OFF_AB - OFF_QH >= TT * 11264 && OFF_DC - OFF_AB >= TT * 5632 && TT * 2048 >= (size_t)256 * 512 * 256, "alias spans");
constexpr int LDS_BYTES = 135168;
constexpr int PPL = 13;
constexpr int SPB = PPL * NL;
constexpr int NSTEPS = 1 + NSB * SPB;

struct Params {
  const float* x_prompt; const float* x_sample; const float* p_prompt; const float* p_sample;
  const float* w_in; const float* lb_logits; const float* gnorm; const float* dlam; const float* subln;
  const float* w_a; const float* w_b; const float* w_out; const float* n_mix_pre; const float* n_mix_post;
  const float* w_up; const float* conv_w; const float* conv_b; const float* w_down; const float* n_ffn_pre; const float* n_ffn_post;
  const float* w_ple; const float* w_pg; const float* n_ple;
  float* out; unsigned char* ws;
};

typedef __bf16 bf16x2_t __attribute__((ext_vector_type(2)));
typedef float f32x2_t __attribute__((ext_vector_type(2)));
__device__ __forceinline__ unsigned cvtpk(float lo, float hi) { f32x2_t v = {lo, hi}; bf16x2_t b = __builtin_convertvector(v, bf16x2_t); return __builtin_bit_cast(unsigned, b); }
__device__ __forceinline__ float bf2f(unsigned short b) { return __uint_as_float(((unsigned)b) << 16); }
__device__ __forceinline__ float bflo(unsigned w) { return __uint_as_float(w << 16); }
__device__ __forceinline__ float bfhi(unsigned w) { return __uint_as_float(w & 0xffff0000u); }
__device__ __forceinline__ unsigned short f2bf(float f) { return (unsigned short)(cvtpk(f, 0.f) & 0xffffu); }
__device__ __forceinline__ float fexp(float x) { return __builtin_amdgcn_exp2f(x * 1.4426950408889634f); }
__device__ __forceinline__ float sigm(float x) { return __builtin_amdgcn_rcpf(1.f + fexp(-x)); }
__device__ __forceinline__ f32x4 mfma16(bf16x8 a, bf16x8 b, f32x4 c) { return __builtin_amdgcn_mfma_f32_16x16x32_bf16(a, b, c, 0, 0, 0); }
__device__ __forceinline__ int otid() { int t = threadIdx.x; asm volatile("" : "+v"(t)); return t; }
__device__ __forceinline__ int obid() { int t = blockIdx.x; asm volatile("" : "+s"(t)); return t; }
__device__ __forceinline__ float wave_sum(float v) {
#pragma unroll
  for (int o = 32; o >= 1; o >>= 1) v += __shfl_xor(v, o, 64);
  return v;
}

namespace pg8 {
constexpr int BM = 256, BK = 64, HALF = 128, HTB = HALF * BK * 2, STAGE_BYTES = 8 * HTB, NXCD = 8, WGM = 8;
__device__ __forceinline__ int lds_byte(int r, int c) { const int st = (r >> 4) * 2 + (c >> 5), rr = r & 15, cc = c & 31, ob = rr * 64 + cc * 2; return st * 1024 + (ob ^ (((ob >> 9) & 1) << 5)); }
__device__ __forceinline__ void stage_rc(int b, int& R, int& C) { const int st = b / 1024, sb = b % 1024, swz = sb ^ (((sb >> 9) & 1) << 5); R = (st >> 1) * 16 + swz / 64; C = (st & 1) * 32 + (swz % 64) / 2; }
struct Unit { int pm, pn; };
struct Gemm { const bf16_t* A; const bf16_t* Bt; int lda, ldb, M, N, K; };
struct StaticOrder {
  int nM, nN, nwg, G, c;
  __device__ void init(int M, int N, int G_, int c_) { nM = M / BM; nN = N / BM; nwg = nM * nN; G = G_; c = c_; }
  __device__ bool next(int i, Unit& u) const {
    const long L = (long)i * G + c; if (L >= nwg) return false;
    int wgid = (int)L; { const int q = nwg / NXCD, r = nwg % NXCD, xcd = wgid % NXCD, off = wgid / NXCD; wgid = (xcd < r ? xcd * (q + 1) : r * (q + 1) + (xcd - r) * q) + off; }
    const int nig = WGM * nN, gid = wgid / nig, fm = gid * WGM, gsz = (nM - fm) < WGM ? (nM - fm) : WGM;
    u.pm = fm + ((wgid % nig) % gsz); u.pn = (wgid % nig) / gsz; return true;
  }
};

template <class Epi, bool HOOK>
__device__ __forceinline__ void gemm_phase(LAS unsigned char* lds, const Gemm g, const StaticOrder& S, const Epi& E, const int hook_t) {
  const int tid = otid(), wid = __builtin_amdgcn_readfirstlane(tid >> 6), lane = tid & 63, wr = wid >> 2, wc = wid & 3, fr = lane & 15, fq = lane >> 4;
  const int K = g.K, nt = K / BK;
  unsigned voffA[2], voffB[2];
#pragma unroll
  for (int i = 0; i < 2; ++i) { int R, C; stage_rc(tid * 16 + i * 8192, R, C);
    voffA[i] = (unsigned)(R * g.lda + C) * 2u; voffB[i] = (unsigned)(R * g.ldb + C) * 2u; }
  const size_t kstep = (size_t)(BK * 2);
  const size_t hstepA = (size_t)HALF * g.lda * 2, hstepB = (size_t)HALF * g.ldb * 2;
  const size_t tstepA = 2 * hstepA, tstepB = 2 * hstepB;
  const unsigned ldsw = (unsigned)wid * 1024u;
  const int aoff = lds_byte(wr * 64 + fr, fq * 8), boff = lds_byte(wc * 32 + fr, fq * 8);
#define PG8_SA(b, h) (((b) * 2 + (h)) * HTB)
#define PG8_SB(b, h) ((4 + (b) * 2 + (h)) * HTB)
#define PG8_STAGE(bufoff, gbase, voff) do { _Pragma("unroll") for (int _i = 0; _i < 2; ++_i) \
    __builtin_amdgcn_global_load_lds((const unsigned*)((const char*)(gbase) + (voff)[_i]), (LAS unsigned*)(lds + (bufoff) + ldsw + _i * 8192), 16, 0, 0); } while (0)
#define PG8_LDA(dst, b, h) do { _Pragma("unroll") for (int m = 0; m < 4; ++m) _Pragma("unroll") for (int k = 0; k < 2; ++k) dst[m][k] = *(const LAS bf16x8*)(lds + PG8_SA(b, h) + aoff + m * 2048 + k * 1024); } while (0)
#define PG8_LDB(dst, b, h) do { _Pragma("unroll") for (int n = 0; n < 2; ++n) _Pragma("unroll") for (int k = 0; k < 2; ++k) dst[n][k] = *(const LAS bf16x8*)(lds + PG8_SB(b, h) + boff + n * 2048 + k * 1024); } while (0)
#define PG8_MMA(ai, bj, At, Bt) do { __builtin_amdgcn_s_setprio(1); _Pragma("unroll") for (int m = 0; m < 4; ++m) _Pragma("unroll") for (int n = 0; n < 2; ++n) _Pragma("unroll") for (int k = 0; k < 2; ++k) \
    acc[ai][bj][m][n] = __builtin_amdgcn_mfma_f32_16x16x32_bf16(Bt[n][k], At[m][k], acc[ai][bj][m][n], 0, 0, 0); __builtin_amdgcn_s_setprio(0); } while (0)
#define PG8_WAIT_V(n) asm volatile("s_waitcnt vmcnt(" #n ")" ::: "memory")
#define PG8_WAIT_L(n) asm volatile("s_waitcnt lgkmcnt(" #n ")" ::: "memory")
#define PG8_BAR __builtin_amdgcn_s_barrier()
#define PG8_SCHED __builtin_amdgcn_sched_barrier(0)
  Unit cur, nxt; int ui = 0;
  if (!S.next(0, cur)) return;
  f32x4 acc[2][2][4][2];
#pragma unroll
  for (int a = 0; a < 2; ++a)
#pragma unroll
    for (int b = 0; b < 2; ++b)
#pragma unroll
      for (int m = 0; m < 4; ++m)
#pragma unroll
        for (int n = 0; n < 2; ++n) acc[a][b][m][n] = (f32x4){0.f, 0.f, 0.f, 0.f};
  bf16x8 At[4][2], B0[2][2], B1[2][2];
  const char* cA = (const char*)g.A + (size_t)cur.pm * tstepA; const char* cB = (const char*)g.Bt + (size_t)cur.pn * tstepB;
  PG8_STAGE(PG8_SB(0, 0), cB, voffB); PG8_STAGE(PG8_SA(0, 0), cA, voffA); PG8_STAGE(PG8_SB(0, 1), cB + hstepB, voffB); PG8_STAGE(PG8_SA(0, 1), cA + hstepA, voffA);
  if (wr == 1) PG8_BAR;
  PG8_WAIT_V(4); PG8_BAR;
  PG8_STAGE(PG8_SB(1, 0), cB + kstep, voffB); PG8_STAGE(PG8_SA(1, 0), cA + kstep, voffA); PG8_STAGE(PG8_SB(1, 1), cB + hstepB + kstep, voffB);
  PG8_WAIT_V(6); PG8_BAR;
  for (;;) {
    const bool has_next = S.next(ui + 1, nxt);
    const char* nA = has_next ? (const char*)g.A + (size_t)nxt.pm * tstepA : cA; const char* nB = has_next ? (const char*)g.Bt + (size_t)nxt.pn * tstepB : cB;
    for (int t = 0; t < nt; t += 2) {
      const bool last = (t == nt - 2);
      const char* a1 = cA + (size_t)(t + 1) * kstep;
      const char* a2 = last ? nA : cA + (size_t)(t + 2) * kstep; const char* b2 = last ? nB : cB + (size_t)(t + 2) * kstep;
      const char* a3 = a2 + kstep; const char* b3 = b2 + kstep;
      if (HOOK) { if (t == hook_t) E.hook(acc, cur.pm, cur.pn, wr, wc, fr, fq); }
      PG8_LDB(B0, 0, 0); PG8_SCHED; PG8_LDA(At, 0, 0); PG8_STAGE(PG8_SA(1, 1), a1 + hstepA, voffA);
      PG8_WAIT_L(8); PG8_BAR; PG8_WAIT_L(0); PG8_MMA(0, 0, At, B0); PG8_BAR; PG8_SCHED;
      PG8_LDB(B1, 0, 1); PG8_STAGE(PG8_SB(0, 0), b2, voffB);
      PG8_BAR; PG8_WAIT_L(0); PG8_MMA(0, 1, At, B1); PG8_BAR;
      PG8_LDA(At, 0, 1); PG8_STAGE(PG8_SA(0, 0), a2, voffA);
      PG8_BAR; PG8_WAIT_L(0); PG8_MMA(1, 0, At, B0); PG8_BAR; PG8_SCHED;
      PG8_STAGE(PG8_SB(0, 1), b2 + hstepB, voffB);
      PG8_WAIT_V(6); PG8_BAR; PG8_MMA(1, 1, At, B1); PG8_BAR;
      PG8_LDB(B0, 1, 0); PG8_SCHED; PG8_LDA(At, 1, 0); PG8_STAGE(PG8_SA(0, 1), a2 + hstepA, voffA);
      PG8_WAIT_L(8); PG8_BAR; PG8_WAIT_L(0); PG8_MMA(0, 0, At, B0); PG8_BAR; PG8_SCHED;
      PG8_LDB(B1, 1, 1); PG8_STAGE(PG8_SB(1, 0), b3, voffB);
      PG8_BAR; PG8_WAIT_L(0); PG8_MMA(0, 1, At, B1); PG8_BAR;
      PG8_LDA(At, 1, 1); PG8_STAGE(PG8_SA(1, 0), a3, voffA);
      PG8_BAR; PG8_WAIT_L(0); PG8_MMA(1, 0, At, B0); PG8_BAR; PG8_SCHED;
      PG8_STAGE(PG8_SB(1, 1), b3 + hstepB, voffB);
      PG8_WAIT_V(6); PG8_BAR; PG8_MMA(1, 1, At, B1); PG8_BAR;
    }
    E(acc, cur.pm, cur.pn, wr, wc, fr, fq);
    if (!has_next) break;
#pragma unroll
    for (int a = 0; a < 2; ++a)
#pragma unroll
      for (int b = 0; b < 2; ++b)
#pragma unroll
        for (int m = 0; m < 4; ++m)
#pragma unroll
          for (int n = 0; n < 2; ++n) acc[a][b][m][n] = (f32x4){0.f, 0.f, 0.f, 0.f};
    cur = nxt; cA = nA; cB = nB; ++ui;
  }
  PG8_WAIT_V(0);
  if (wr == 0) PG8_BAR;
  PG8_BAR;
#undef PG8_SA
#undef PG8_SB
#undef PG8_STAGE
#undef PG8_LDA
#undef PG8_LDB
#undef PG8_MMA
#undef PG8_WAIT_V
#undef PG8_WAIT_L
#undef PG8_BAR
#undef PG8_SCHED
}
}

typedef f32x4 AccT[2][2][4][2];

struct EpiPlain {
  bf16_t* C; int ldc;
  __device__ __forceinline__ void hook(AccT& acc, int pm, int pn, int wr, int wc, int fr, int fq) const {}
  __device__ __forceinline__ void operator()(const AccT& acc, int pm, int pn, int wr, int wc, int fr, int fq) const {
    const int row0 = pm * 256 + wr * 64 + fr, col0 = pn * 256 + wc * 32 + 8 * fq;
#pragma unroll
    for (int ai = 0; ai < 2; ++ai)
#pragma unroll
      for (int m = 0; m < 4; ++m) { bf16_t* rowp = C + (size_t)(row0 + ai * 128 + m * 16) * ldc + col0;
#pragma unroll
        for (int bj = 0; bj < 2; ++bj) { const f32x4 v0 = acc[ai][bj][m][0], v1 = acc[ai][bj][m][1];
          u32x4 w = {cvtpk(v0[0], v0[1]), cvtpk(v0[2], v0[3]), cvtpk(v1[0], v1[1]), cvtpk(v1[2], v1[3])}; *(u32x4*)(rowp + bj * 128) = w; } }
  }
};

struct EpiWin {
  unsigned char* ws; int l; int Lmask;
  __device__ __forceinline__ void hook(AccT& acc, int pm, int pn, int wr, int wc, int fr, int fq) const {}
  __device__ __forceinline__ void operator()(const AccT& acc, int pm, int pn, int wr, int wc, int fr, int fq) const {
    const int row0 = pm * 256 + wr * 64 + fr;
    if (pn >= 16) {
      bf16_t* G = (bf16_t*)(ws + (((pn - 16) >> 2) ? OFF_GB : OFF_GA));
      const int col0 = ((pn - 16) & 3) * 256 + wc * 32 + 8 * fq;
#pragma unroll
      for (int ai = 0; ai < 2; ++ai)
#pragma unroll
        for (int m = 0; m < 4; ++m) { bf16_t* rowp = G + (size_t)(row0 + ai * 128 + m * 16) * 1024 + col0;
#pragma unroll
          for (int bj = 0; bj < 2; ++bj) { const f32x4 v0 = acc[ai][bj][m][0], v1 = acc[ai][bj][m][1];
            u32x4 w = {cvtpk(sigm(v0[0]), sigm(v0[1])), cvtpk(sigm(v0[2]), sigm(v0[3])), cvtpk(sigm(v1[0]), sigm(v1[1])), cvtpk(sigm(v1[2]), sigm(v1[3]))};
            *(u32x4*)(rowp + bj * 128) = w; } }
      return;
    }
    const int seg = pn >> 1;
    const int cin = (pn & 1) * 256 + wc * 32 + 8 * fq;
    if (seg == 1 || seg == 2) {
      const int dir = seg - 1;
      float* GF = (float*)(ws + OFF_GF);
      const float* LB = (const float*)(ws + OFF_LB) + l * 1024 + dir * 512;
#pragma unroll
      for (int bj = 0; bj < 2; ++bj)
#pragma unroll
        for (int n = 0; n < 2; ++n) { const int c = cin + bj * 128 + n * 4; const f32x4 lb = *(const f32x4*)(LB + c);
#pragma unroll
          for (int ai = 0; ai < 2; ++ai)
#pragma unroll
            for (int m = 0; m < 4; ++m) { const f32x4 v = acc[ai][bj][m][n]; f32x4 o;
#pragma unroll
              for (int j = 0; j < 4; ++j) o[j] = __logf(fmaxf(lb[j], 1e-30f) + (1.f - lb[j]) * sigm(v[j]));
              *(f32x4*)(GF + (size_t)(row0 + ai * 128 + m * 16) * 1024 + dir * 512 + c) = o; } }
      return;
    }
    if (seg == 5 || seg == 6) {
      bf16_t* dst = (bf16_t*)(ws + (seg == 5 ? OFF_QD : OFF_KD));
      const float sc = seg == 5 ? 0.125f : 1.f;
      const float* COS = (const float*)(ws + OFF_COS); const float* SIN = (const float*)(ws + OFF_SIN);
      const int jj = 8 * fq;
#pragma unroll
      for (int ai = 0; ai < 2; ++ai)
#pragma unroll
        for (int m = 0; m < 4; ++m) { const int row = row0 + ai * 128 + m * 16; const int pos = row & Lmask;
          float o1[8], o2[8];
#pragma unroll
          for (int n = 0; n < 2; ++n) { const f32x4 cs = *(const f32x4*)(COS + pos * 32 + jj + 4 * n), sn = *(const f32x4*)(SIN + pos * 32 + jj + 4 * n);
            const f32x4 x1 = acc[ai][0][m][n], x2 = acc[ai][1][m][n];
#pragma unroll
            for (int j = 0; j < 4; ++j) { o1[4 * n + j] = (x1[j] * cs[j] - x2[j] * sn[j]) * sc; o2[4 * n + j] = (x2[j] * cs[j] + x1[j] * sn[j]) * sc; } }
          bf16_t* bp = dst + (size_t)row * 512 + (pn & 1) * 256 + wc * 64 + jj;
          u32x4 w1 = {cvtpk(o1[0], o1[1]), cvtpk(o1[2], o1[3]), cvtpk(o1[4], o1[5]), cvtpk(o1[6], o1[7])};
          u32x4 w2 = {cvtpk(o2[0], o2[1]), cvtpk(o2[2], o2[3]), cvtpk(o2[4], o2[5]), cvtpk(o2[6], o2[7])};
          *(u32x4*)bp = w1; *(u32x4*)(bp + 32) = w2; }
      return;
    }
    bf16_t* dst = (bf16_t*)(ws + (seg == 0 ? OFF_QH : seg == 3 ? OFF_VH : seg == 4 ? OFF_GG : OFF_VD));
    const int mode = seg == 0 ? 1 : (seg == 4 ? 2 : 0);
#pragma unroll
    for (int ai = 0; ai < 2; ++ai)
#pragma unroll
      for (int m = 0; m < 4; ++m) { bf16_t* rowp = dst + (size_t)(row0 + ai * 128 + m * 16) * 512 + cin;
#pragma unroll
        for (int bj = 0; bj < 2; ++bj) { f32x4 v0 = acc[ai][bj][m][0], v1 = acc[ai][bj][m][1];
          if (mode) {
#pragma unroll
            for (int j = 0; j < 4; ++j) { v0[j] = v0[j] * sigm(v0[j]) * (mode == 1 ? 0.08838834764831845f : 1.f); v1[j] = v1[j] * sigm(v1[j]) * (mode == 1 ? 0.08838834764831845f : 1.f); } }
          u32x4 w = {cvtpk(v0[0], v0[1]), cvtpk(v0[2], v0[3]), cvtpk(v1[0], v1[1]), cvtpk(v1[2], v1[3])}; *(u32x4*)(rowp + bj * 128) = w; } }
  }
};

template <int SECOND> struct EpiGate {
  const bf16_t* G; bf16_t* M;
  __device__ __forceinline__ void hook(AccT& acc, int pm, int pn, int wr, int wc, int fr, int fq) const {}
  __device__ __forceinline__ void operator()(const AccT& acc, int pm, int pn, int wr, int wc, int fr, int fq) const {
    const unsigned voff = (unsigned)(fr * 1024 + 8 * fq) * 2u;
    const size_t ub = ((size_t)(pm * 256 + wr * 64) * 1024 + pn * 256 + wc * 32) * 2;
#pragma unroll
    for (int ai = 0; ai < 2; ++ai)
#pragma unroll
      for (int m = 0; m < 4; ++m) { const char* gb = (const char*)G + ub + (size_t)(ai * 128 + m * 16) * 2048; char* mo = (char*)M + ub + (size_t)(ai * 128 + m * 16) * 2048;
#pragma unroll
        for (int bj = 0; bj < 2; ++bj) { const u32x4 b = *(const u32x4*)(gb + voff + bj * 256); const f32x4 v0 = acc[ai][bj][m][0], v1 = acc[ai][bj][m][1];
          float r[8] = {v0[0] * bflo(b[0]), v0[1] * bfhi(b[0]), v0[2] * bflo(b[1]), v0[3] * bfhi(b[1]), v1[0] * bflo(b[2]), v1[1] * bfhi(b[2]), v1[2] * bflo(b[3]), v1[3] * bfhi(b[3])};
          if (SECOND) { const u32x4 pm_ = *(const u32x4*)(mo + voff + bj * 256);
#pragma unroll
            for (int q = 0; q < 4; ++q) { r[2 * q] += bflo(pm_[q]); r[2 * q + 1] += bfhi(pm_[q]); } }
          u32x4 w = {cvtpk(r[0], r[1]), cvtpk(r[2], r[3]), cvtpk(r[4], r[5]), cvtpk(r[6], r[7])};
          *(u32x4*)(mo + voff + bj * 256) = w; } }
  }
};

struct EpiMerge {
  const bf16_t* GA; const bf16_t* GB; bf16_t* M;
  __device__ __forceinline__ void hook(AccT& acc, int pm, int pn, int wr, int wc, int fr, int fq) const {
    const int t_ = otid();
    const unsigned voff = (unsigned)((t_ & 15) * 1024 + 8 * ((t_ >> 4) & 3)) * 2u;
    const size_t ub = ((size_t)(pm * 256 + wr * 64) * 1024 + pn * 256 + wc * 32) * 2;
#pragma unroll
    for (int ai = 0; ai < 2; ++ai)
#pragma unroll
      for (int m = 0; m < 4; ++m) { const char* ga = (const char*)GA + ub + (size_t)(ai * 128 + m * 16) * 2048; const char* gb = (const char*)GB + ub + (size_t)(ai * 128 + m * 16) * 2048;
#pragma unroll
        for (int bj = 0; bj < 2; ++bj) { const u32x4 a = __builtin_nontemporal_load((const u32x4*)(ga + voff + bj * 256)), b = *(const u32x4*)(gb + voff + bj * 256);
          f32x4 v0 = acc[ai][bj][m][0], v1 = acc[ai][bj][m][1];
          v0[0] *= bflo(a[0]) * __builtin_amdgcn_rcpf(fmaxf(bflo(b[0]), 1e-30f)); v0[1] *= bfhi(a[0]) * __builtin_amdgcn_rcpf(fmaxf(bfhi(b[0]), 1e-30f));
          v0[2] *= bflo(a[1]) * __builtin_amdgcn_rcpf(fmaxf(bflo(b[1]), 1e-30f)); v0[3] *= bfhi(a[1]) * __builtin_amdgcn_rcpf(fmaxf(bfhi(b[1]), 1e-30f));
          v1[0] *= bflo(a[2]) * __builtin_amdgcn_rcpf(fmaxf(bflo(b[2]), 1e-30f)); v1[1] *= bfhi(a[2]) * __builtin_amdgcn_rcpf(fmaxf(bfhi(b[2]), 1e-30f));
          v1[2] *= bflo(a[3]) * __builtin_amdgcn_rcpf(fmaxf(bflo(b[3]), 1e-30f)); v1[3] *= bfhi(a[3]) * __builtin_amdgcn_rcpf(fmaxf(bfhi(b[3]), 1e-30f));
          acc[ai][bj][m][0] = v0; acc[ai][bj][m][1] = v1; __builtin_amdgcn_sched_barrier(0); } }
  }
  __device__ __forceinline__ void operator()(const AccT& acc, int pm, int pn, int wr, int wc, int fr, int fq) const {
    const int t_ = otid();
    const unsigned voff = (unsigned)((t_ & 15) * 1024 + 8 * ((t_ >> 4) & 3)) * 2u;
    const size_t ub = ((size_t)(pm * 256 + wr * 64) * 1024 + pn * 256 + wc * 32) * 2;
#pragma unroll
    for (int ai = 0; ai < 2; ++ai)
#pragma unroll
      for (int m = 0; m < 4; ++m) { const char* gb = (const char*)GB + ub + (size_t)(ai * 128 + m * 16) * 2048; char* mo = (char*)M + ub + (size_t)(ai * 128 + m * 16) * 2048;
#pragma unroll
        for (int bj = 0; bj < 2; ++bj) { const u32x4 b = *(const u32x4*)(gb + voff + bj * 256); const f32x4 v0 = acc[ai][bj][m][0], v1 = acc[ai][bj][m][1];
          u32x4 w = {cvtpk(v0[0] * bflo(b[0]), v0[1] * bfhi(b[0])), cvtpk(v0[2] * bflo(b[1]), v0[3] * bfhi(b[1])), cvtpk(v1[0] * bflo(b[2]), v1[1] * bfhi(b[2])), cvtpk(v1[2] * bflo(b[3]), v1[3] * bfhi(b[3]))};
          *(u32x4*)(mo + voff + bj * 256) = w; } }
  }
};

struct EpiPle {
  bf16_t* GE;
  __device__ __forceinline__ void hook(AccT& acc, int pm, int pn, int wr, int wc, int fr, int fq) const {
    const int row0 = pm * 256 + wr * 64 + fr, col0 = pn * 256 + wc * 32 + 8 * fq;
#pragma unroll
    for (int ai = 0; ai < 2; ++ai)
#pragma unroll
      for (int m = 0; m < 4; ++m) { const size_t ro = (size_t)(row0 + ai * 128 + m * 16) * 1024 + col0;
#pragma unroll
        for (int bj = 0; bj < 2; ++bj) { const f32x4 v0 = acc[ai][bj][m][0], v1 = acc[ai][bj][m][1];
          u32x4 w = {cvtpk(v0[0], v0[1]), cvtpk(v0[2], v0[3]), cvtpk(v1[0], v1[1]), cvtpk(v1[2], v1[3])};
          *(u32x4*)(GE + ro + bj * 128) = w; acc[ai][bj][m][0] = (f32x4){0.f, 0.f, 0.f, 0.f}; acc[ai][bj][m][1] = (f32x4){0.f, 0.f, 0.f, 0.f}; } }
  }
  __device__ __forceinline__ void operator()(const AccT& acc, int pm, int pn, int wr, int wc, int fr, int fq) const {
    const int row0 = pm * 256 + wr * 64 + fr, col0 = pn * 256 + wc * 32 + 8 * fq;
#pragma unroll
    for (int ai = 0; ai < 2; ++ai)
#pragma unroll
      for (int m = 0; m < 4; ++m) { const size_t ro = (size_t)(row0 + ai * 128 + m * 16) * 1024 + col0;
#pragma unroll
        for (int bj = 0; bj < 2; ++bj) { const u32x4 e = *(const u32x4*)(GE + ro + bj * 128); const f32x4 v0 = acc[ai][bj][m][0], v1 = acc[ai][bj][m][1];
          u32x4 w = {cvtpk(sigm(v0[0]) * bflo(e[0]), sigm(v0[1]) * bfhi(e[0])), cvtpk(sigm(v0[2]) * bflo(e[1]), sigm(v0[3]) * bfhi(e[1])),
                     cvtpk(sigm(v1[0]) * bflo(e[2]), sigm(v1[1]) * bfhi(e[2])), cvtpk(sigm(v1[2]) * bflo(e[3]), sigm(v1[3]) * bfhi(e[3]))};
          *(u32x4*)(GE + ro + bj * 128) = w; } }
  }
};

__device__ __forceinline__ void transpose_tile(const float* __restrict__ src, int N, bf16_t* __restrict__ dst, int ldb, int koff, int kt, int ntile, int perm_mode, float* ldsf) {
  const int tid = otid();
  const int k0 = kt * 64, n0 = ntile * 64;
  { const int r = tid >> 4, c4 = (tid & 15) * 4;
#pragma unroll
    for (int h = 0; h < 2; ++h) { const int rr = r + h * 32; const f32x4 v = __builtin_nontemporal_load((const f32x4*)(src + (size_t)(k0 + rr) * N + n0 + c4));
      ldsf[rr * 65 + c4 + 0] = v[0]; ldsf[rr * 65 + c4 + 1] = v[1]; ldsf[rr * 65 + c4 + 2] = v[2]; ldsf[rr * 65 + c4 + 3] = v[3]; } }
  __syncthreads();
  { const int n = tid >> 3, k8 = (tid & 7) * 8;
    float v[8];
#pragma unroll
    for (int i = 0; i < 8; ++i) v[i] = ldsf[(k8 + i) * 65 + n];
    int c = n0 + n;
    const bool rope_cols = (perm_mode == 3) && c >= 2560 && c < 3584;
    if (rope_cols) { const int cl = c & 255, b = cl >> 6, half = (cl >> 5) & 1, jj = cl & 31;
      c = (c & ~255) + 128 * half + 32 * b + 16 * ((jj >> 2) & 1) + 4 * ((jj >> 3) & 3) + (jj & 3); }
    if (perm_mode == 2 || (perm_mode == 3 && !rope_cols)) c = (c & ~31) + 16 * ((c >> 2) & 1) + 4 * ((c >> 3) & 3) + (c & 3);
    u32x4 w = {cvtpk(v[0], v[1]), cvtpk(v[2], v[3]), cvtpk(v[4], v[5]), cvtpk(v[6], v[7])};
    *(u32x4*)(dst + (size_t)c * ldb + koff + k0 + k8) = w; }
  __syncthreads();
}

__device__ void prep_phase(const Params& p, unsigned char* smem) {
  float* ldsf = (float*)smem;
  const int TPL = 4480;
  for (int tl = blockIdx.x; tl < TPL * NL; tl += gridDim.x) {
    const int l = tl / TPL; int r = tl % TPL;
    unsigned char* wl = p.ws + (size_t)l * SZ_WL;
    if (r < 1536) { transpose_tile(p.w_in + (size_t)l * 1024 * INC, INC, (bf16_t*)(wl + OFF_WIN), 1024, 0, r / 96, r % 96, 3, ldsf); continue; } r -= 1536;
    if (r < 128) { transpose_tile(p.w_a + (size_t)l * 512 * 1024, 1024, (bf16_t*)(wl + OFF_WAB), 1024, 0, r / 16, r % 16, 2, ldsf); continue; } r -= 128;
    if (r < 128) { transpose_tile(p.w_b + (size_t)l * 512 * 1024, 1024, (bf16_t*)(wl + OFF_WAB), 1024, 512, r / 16, r % 16, 2, ldsf); continue; } r -= 128;
    if (r < 256) { transpose_tile(p.w_out + (size_t)l * 1024 * 1024, 1024, (bf16_t*)(wl + OFF_WOUT), 1024, 0, r / 16, r % 16, 2, ldsf); continue; } r -= 256;
    if (r < 1408) { transpose_tile(p.w_up + (size_t)l * 1024 * FF2, FF2, (bf16_t*)(wl + OFF_WUP), 1024, 0, r / 88, r % 88, 2, ldsf); continue; } r -= 1408;
    if (r < 704) { transpose_tile(p.w_down + (size_t)l * FF * 1024, 1024, (bf16_t*)(wl + OFF_WDOWN), FF, 0, r / 16, r % 16, 2, ldsf); continue; } r -= 704;
    if (r < 64) { transpose_tile(p.w_ple + (size_t)l * 256 * 1024, 1024, (bf16_t*)(wl + OFF_WPG), 1280, 0, r / 16, r % 16, 2, ldsf); continue; } r -= 64;
    transpose_tile(p.w_pg + (size_t)l * 1024 * 1024, 1024, (bf16_t*)(wl + OFF_WPG), 1280, 256, r / 16, r % 16, 2, ldsf);
  }
  const int gt = obid() * 512 + otid(), gn = gridDim.x * 512;
  float* LB = (float*)(p.ws + OFF_LB); float* LAM = (float*)(p.ws + OFF_LAM);
  float* COS = (float*)(p.ws + OFF_COS); float* SIN = (float*)(p.ws + OFF_SIN);
  for (int i = gt; i < 1024; i += gn) {
    const float x0 = p.lb_logits[i], x1 = p.lb_logits[1024 + i], x2 = p.lb_logits[2048 + i], x3 = p.lb_logits[3072 + i];
    const float mx = fmaxf(fmaxf(x0, x1), fmaxf(x2, x3));
    const float e0 = expf(x0 - mx), e1 = expf(x1 - mx), e2 = expf(x2 - mx), e3 = expf(x3 - mx), s = e0 + e1 + e2 + e3;
    LB[i] = 0.f; LB[1024 + i] = e1 / s; LB[2048 + i] = (e1 + e2) / s; LB[3072 + i] = (e1 + e2 + e3) / s;
  }
  if (gt < NL) {
    const float* lp = p.dlam + gt * 256; float d1 = 0.f, d2 = 0.f;
    for (int i = 0; i < 64; ++i) { d1 += lp[i] * lp[64 + i]; d2 += lp[128 + i] * lp[192 + i]; }
    const float li = 0.8f - 0.6f * expf(-0.3f * (float)gt);
    LAM[gt] = expf(d1) - expf(d2) + li; LAM[8 + gt] = 1.f - li;
  }
  for (int i = gt; i < 4096 * 32; i += gn) {
    const int pos = i >> 5, j = i & 31;
    const float inv = 1.0f / exp2f((float)j * (13.287712379549449f / 32.f));
    const float ang = (float)pos * inv;
    double rev = (double)ang * 0.15915494309189535; rev -= rint(rev);
    COS[i] = __builtin_amdgcn_cosf((float)rev); SIN[i] = __builtin_amdgcn_sinf((float)rev);
  }
}

__device__ void rowwise_phase(const float* __restrict__ xin, float* __restrict__ xres, const bf16_t* __restrict__ y, const float* __restrict__ w_post,
                              const float* __restrict__ w_next, bool do_next, bf16_t* __restrict__ Hout, int ldh, int hoff, const float* __restrict__ p_src, int T, bool final_f32) {
  const int tid_ = otid(); const int wid = tid_ >> 6, lane = tid_ & 63;
  for (int row = obid() * 8 + wid; row < T; row += gridDim.x * 8) {
    float x[16];
    if (y) {
#pragma unroll
      for (int c = 0; c < 2; ++c) { const u32x4 w = __builtin_nontemporal_load((const u32x4*)((const bf16_t*)(xres + (size_t)row * 1024) + c * 512 + lane * 8));
#pragma unroll
        for (int i = 0; i < 4; ++i) { x[c * 8 + 2 * i] = bflo(w[i]); x[c * 8 + 2 * i + 1] = bfhi(w[i]); } }
    } else {
#pragma unroll
      for (int c = 0; c < 2; ++c) { const float* xp = xin + (size_t)row * 1024 + c * 512 + lane * 8;
        const f32x4 a = __builtin_nontemporal_load((const f32x4*)xp), b = __builtin_nontemporal_load((const f32x4*)(xp + 4));
        x[c * 8 + 0] = a[0]; x[c * 8 + 1] = a[1]; x[c * 8 + 2] = a[2]; x[c * 8 + 3] = a[3]; x[c * 8 + 4] = b[0]; x[c * 8 + 5] = b[1]; x[c * 8 + 6] = b[2]; x[c * 8 + 7] = b[3]; }
    }
    if (y) {
      float yv[16]; float ss = 0.f;
#pragma unroll
      for (int c = 0; c < 2; ++c) { const u32x4 w = __builtin_nontemporal_load((const u32x4*)(y + (size_t)row * 1024 + c * 512 + lane * 8));
#pragma unroll
        for (int i = 0; i < 4; ++i) { yv[c * 8 + 2 * i] = bflo(w[i]); yv[c * 8 + 2 * i + 1] = bfhi(w[i]); } }
#pragma unroll
      for (int i = 0; i < 16; ++i) ss += yv[i] * yv[i];
      ss = wave_sum(ss);
      const float rs = rsqrtf(ss * (1.f / 1024.f) + EPS);
#pragma unroll
      for (int c = 0; c < 2; ++c) { const float* wp = w_post + c * 512 + lane * 8; const f32x4 a = *(const f32x4*)wp, b = *(const f32x4*)(wp + 4);
        x[c * 8 + 0] += yv[c * 8 + 0] * rs * a[0]; x[c * 8 + 1] += yv[c * 8 + 1] * rs * a[1]; x[c * 8 + 2] += yv[c * 8 + 2] * rs * a[2]; x[c * 8 + 3] += yv[c * 8 + 3] * rs * a[3];
        x[c * 8 + 4] += yv[c * 8 + 4] * rs * b[0]; x[c * 8 + 5] += yv[c * 8 + 5] * rs * b[1]; x[c * 8 + 6] += yv[c * 8 + 6] * rs * b[2]; x[c * 8 + 7] += yv[c * 8 + 7] * rs * b[3]; }
    }
    if (final_f32) {
#pragma unroll
      for (int c = 0; c < 2; ++c) { float* xp = xres + (size_t)row * 1024 + c * 512 + lane * 8;
        __builtin_nontemporal_store((f32x4){x[c * 8 + 0], x[c * 8 + 1], x[c * 8 + 2], x[c * 8 + 3]}, (f32x4*)xp); __builtin_nontemporal_store((f32x4){x[c * 8 + 4], x[c * 8 + 5], x[c * 8 + 6], x[c * 8 + 7]}, (f32x4*)(xp + 4)); }
    } else {
#pragma unroll
      for (int c = 0; c < 2; ++c) { u32x4 w;
#pragma unroll
        for (int i = 0; i < 4; ++i) w[i] = cvtpk(x[c * 8 + 2 * i], x[c * 8 + 2 * i + 1]);
        __builtin_nontemporal_store(w, (u32x4*)((bf16_t*)(xres + (size_t)row * 1024) + c * 512 + lane * 8)); }
    }
    if (do_next) {
      float s2 = 0.f;
#pragma unroll
      for (int i = 0; i < 16; ++i) s2 += x[i] * x[i];
      s2 = wave_sum(s2);
      const float r2 = rsqrtf(s2 * (1.f / 1024.f) + EPS);
#pragma unroll
      for (int c = 0; c < 2; ++c) { float wv[8];
        if (w_next) { const float* wp = w_next + c * 512 + lane * 8; const f32x4 a = *(const f32x4*)wp, b = *(const f32x4*)(wp + 4);
          wv[0] = a[0]; wv[1] = a[1]; wv[2] = a[2]; wv[3] = a[3]; wv[4] = b[0]; wv[5] = b[1]; wv[6] = b[2]; wv[7] = b[3]; }
        else {
#pragma unroll
          for (int i = 0; i < 8; ++i) wv[i] = 1.f; }
        u32x4 w;
#pragma unroll
        for (int i = 0; i < 4; ++i) w[i] = cvtpk(x[c * 8 + 2 * i] * r2 * wv[2 * i], x[c * 8 + 2 * i + 1] * r2 * wv[2 * i + 1]);
        *(u32x4*)(Hout + (size_t)row * ldh + hoff + c * 512 + lane * 8) = w; }
      if (p_src) { const f32x4 pv = __builtin_nontemporal_load((const f32x4*)(p_src + (size_t)row * 256 + lane * 4));
        u32x2 w = {cvtpk(pv[0], pv[1]), cvtpk(pv[2], pv[3])}; *(u32x2*)(Hout + (size_t)row * ldh + lane * 4) = w; }
    }
  }
}

__device__ void conv_phase(const bf16_t* __restrict__ U, const float* __restrict__ cw, const float* __restrict__ cb, bf16_t* __restrict__ ACT, int Lmask, int T) {
  const int gt = obid() * 512 + otid(), gn = gridDim.x * 512;
  for (int u = gt; u < (T / 16) * 352; u += gn) {
    const int j8 = u % 352, rb = u / 352, r0 = rb * 16, c0 = j8 * 8;
    float w0g[8], w1g[8], w2g[8], bg[8], w0v[8], w1v[8], w2v[8], bv[8];
#pragma unroll
    for (int i = 0; i < 8; ++i) { w0g[i] = cw[c0 + i]; w1g[i] = cw[FF2 + c0 + i]; w2g[i] = cw[2 * FF2 + c0 + i]; bg[i] = cb[c0 + i];
      w0v[i] = cw[FF + c0 + i]; w1v[i] = cw[FF2 + FF + c0 + i]; w2v[i] = cw[2 * FF2 + FF + c0 + i]; bv[i] = cb[FF + c0 + i]; }
    const u32x4 z4 = {0u, 0u, 0u, 0u};
    u32x4 pg = z4, pv = z4, cg_ = z4, cv = z4, ng, nv;
    if ((r0 & Lmask) != 0) { pg = __builtin_nontemporal_load((const u32x4*)(U + (size_t)(r0 - 1) * FF2 + c0)); pv = __builtin_nontemporal_load((const u32x4*)(U + (size_t)(r0 - 1) * FF2 + FF + c0)); }
    cg_ = __builtin_nontemporal_load((const u32x4*)(U + (size_t)r0 * FF2 + c0)); cv = __builtin_nontemporal_load((const u32x4*)(U + (size_t)r0 * FF2 + FF + c0));
    for (int i = 0; i < 16; ++i) {
      const int row = r0 + i;
      if (((row + 1) & Lmask) != 0) { ng = __builtin_nontemporal_load((const u32x4*)(U + (size_t)(row + 1) * FF2 + c0)); nv = __builtin_nontemporal_load((const u32x4*)(U + (size_t)(row + 1) * FF2 + FF + c0)); }
      else { ng = z4; nv = z4; }
      float o[8];
#pragma unroll
      for (int q = 0; q < 4; ++q) {
#pragma unroll
        for (int hh = 0; hh < 2; ++hh) { const int e = q * 2 + hh;
          const float gp = hh ? bfhi(pg[q]) : bflo(pg[q]), gc = hh ? bfhi(cg_[q]) : bflo(cg_[q]), gnx = hh ? bfhi(ng[q]) : bflo(ng[q]);
          const float vp = hh ? bfhi(pv[q]) : bflo(pv[q]), vc = hh ? bfhi(cv[q]) : bflo(cv[q]), vnx = hh ? bfhi(nv[q]) : bflo(nv[q]);
          const float g = gp * w0g[e] + gc * w1g[e] + gnx * w2g[e] + bg[e];
          const float v = vp * w0v[e] + vc * w1v[e] + vnx * w2v[e] + bv[e];
          const float ge = g * sigm(1.5957691216057308f * (g + 0.044715f * g * g * g));
          o[e] = ge * v; } }
      u32x4 w = {cvtpk(o[0], o[1]), cvtpk(o[2], o[3]), cvtpk(o[4], o[5]), cvtpk(o[6], o[7])};
      *(u32x4*)(ACT + (size_t)row * FF + c0) = w;
      pg = cg_; pv = cv; cg_ = ng; cv = nv;
    }
  }
}

__device__ void hg_delta_phase(const Params& p, unsigned char* smem, int T) {
  const int tid = otid(), wid = tid >> 6, lane = tid & 63, fr = lane & 15, fq = lane >> 4;
  bf16_t* KT = (bf16_t*)smem;
  bf16_t* VT = KT + 128 * 72;
  float* tot = (float*)(VT + 128 * 72);
  const float* GF = (const float*)(p.ws + OFF_GF); const bf16_t* VH = (const bf16_t*)(p.ws + OFF_VH);
  bf16_t* ST = (bf16_t*)(p.ws + OFF_ST); float* DC = (float*)(p.ws + OFF_DC);
  const int ch = tid & 127, part = tid >> 7;
  for (int item = blockIdx.x; item < (T / 64) * 8; item += gridDim.x) {
    const int d = item & 1, h = (item >> 1) & 3, cgl = item >> 3, t0 = cgl * 64;
    float g[16], pl[16]; float run = 0.f;
#pragma unroll
    for (int i = 0; i < 16; ++i) g[i] = GF[(size_t)(t0 + part * 16 + i) * 1024 + d * 512 + h * 128 + ch];
    unsigned short vv[16];
#pragma unroll
    for (int i = 0; i < 16; ++i) vv[i] = VH[(size_t)(t0 + part * 16 + i) * 512 + h * 128 + ch];
#pragma unroll
    for (int i = 0; i < 16; ++i) { pl[i] = run; run += g[i]; }
    const float lt = run;
    tot[part * 128 + ch] = lt;
    { u32x4 w0, w1;
#pragma unroll
      for (int i = 0; i < 4; ++i) { w0[i] = (unsigned)vv[2 * i] | ((unsigned)vv[2 * i + 1] << 16); w1[i] = (unsigned)vv[8 + 2 * i] | ((unsigned)vv[8 + 2 * i + 1] << 16); }
      *(u32x4*)(VT + ch * 72 + part * 16) = w0; *(u32x4*)(VT + ch * 72 + part * 16 + 8) = w1; }
    __syncthreads();
    const float t0s = tot[ch], t1s = tot[128 + ch], t2s = tot[256 + ch], t3s = tot[384 + ch];
    const float before = (part > 0 ? t0s : 0.f) + (part > 1 ? t1s : 0.f) + (part > 2 ? t2s : 0.f);
    const float after = (part < 1 ? t1s : 0.f) + (part < 2 ? t2s : 0.f) + (part < 3 ? t3s : 0.f);
    if (part == 0) DC[(size_t)item * 128 + ch] = fexp(t0s + t1s + t2s + t3s);
    { float kt[16];
#pragma unroll
      for (int i = 0; i < 16; ++i) { const float E = d == 0 ? after + (lt - pl[i] - g[i]) : before + pl[i]; kt[i] = (1.f - fexp(g[i])) * fexp(E); }
      u32x4 w0, w1;
#pragma unroll
      for (int i = 0; i < 4; ++i) { w0[i] = cvtpk(kt[2 * i], kt[2 * i + 1]); w1[i] = cvtpk(kt[8 + 2 * i], kt[8 + 2 * i + 1]); }
      *(u32x4*)(KT + ch * 72 + part * 16) = w0; *(u32x4*)(KT + ch * 72 + part * 16 + 8) = w1; }
    __syncthreads();
    bf16x8 af[2];
#pragma unroll
    for (int ks = 0; ks < 2; ++ks) af[ks] = *(const bf16x8*)(KT + (wid * 16 + fr) * 72 + ks * 32 + fq * 8);
    bf16_t* Sout = ST + (size_t)item * 16384;
#pragma unroll
    for (int vb = 0; vb < 8; ++vb) { f32x4 c = {0.f, 0.f, 0.f, 0.f};
#pragma unroll
      for (int ks = 0; ks < 2; ++ks) { const bf16x8 bfg = *(const bf16x8*)(VT + (vb * 16 + fr) * 72 + ks * 32 + fq * 8); c = mfma16(af[ks], bfg, c); }
      u32x2 w = {cvtpk(c[0], c[1]), cvtpk(c[2], c[3])};
      *(u32x2*)(Sout + ((wid * 8 + vb) * 64 + lane) * 4) = w; }
    __syncthreads();
  }
}

__device__ void hg_scan_phase(const Params& p, int nseq, int nc) {
  bf16_t* ST = (bf16_t*)(p.ws + OFF_ST); const float* DC = (const float*)(p.ws + OFF_DC);
  const int gt = obid() * 512 + otid(), gn = gridDim.x * 512;
  const int nchain = nseq * 8;
  for (int vi = gt; vi < nchain * 2048; vi += gn) {
    const int chain = vi >> 11, e8 = (vi & 2047) * 8, k0 = 16 * (e8 >> 11) + 4 * ((e8 >> 6) & 3);
    const int d = chain & 1, h = (chain >> 1) & 3, s = chain >> 3;
    float run[8];
#pragma unroll
    for (int i = 0; i < 8; ++i) run[i] = 0.f;
    for (int cc = 0; cc < nc; cc += 8) {
      u32x4 dl[8]; f32x4 da[8];
#pragma unroll
      for (int q = 0; q < 8; ++q) { const int c = d == 0 ? (cc + q) : (nc - 1 - cc - q); const size_t it = (size_t)((s * nc + c) * 4 + h) * 2 + d;
        dl[q] = *(const u32x4*)(ST + it * 16384 + e8); da[q] = *(const f32x4*)(DC + it * 128 + k0); }
#pragma unroll
      for (int q = 0; q < 8; ++q) { const int c = d == 0 ? (cc + q) : (nc - 1 - cc - q); const size_t it = (size_t)((s * nc + c) * 4 + h) * 2 + d;
        u32x4 w = {cvtpk(run[0], run[1]), cvtpk(run[2], run[3]), cvtpk(run[4], run[5]), cvtpk(run[6], run[7])};
        *(u32x4*)(ST + it * 16384 + e8) = w;
        run[0] = da[q][0] * run[0] + bflo(dl[q][0]); run[1] = da[q][1] * run[1] + bfhi(dl[q][0]);
        run[2] = da[q][2] * run[2] + bflo(dl[q][1]); run[3] = da[q][3] * run[3] + bfhi(dl[q][1]);
        run[4] = da[q][0] * run[4] + bflo(dl[q][2]); run[5] = da[q][1] * run[5] + bfhi(dl[q][2]);
        run[6] = da[q][2] * run[6] + bflo(dl[q][3]); run[7] = da[q][3] * run[7] + bfhi(dl[q][3]); }
    }
  }
}

__device__ void hg_out_phase(const Params& p, int l, unsigned char* smem, int T) {
  const int tid = otid(), wid = tid >> 6, lane = tid & 63, fr = lane & 15, fq = lane >> 4;
  bf16_t* QT = (bf16_t*)smem;
  bf16_t* KT2 = QT + 64 * 136;
  bf16_t* QHt = KT2 + 64 * 136;
  bf16_t* VT = QHt + 64 * 136;
  bf16_t* Pm = VT + 128 * 72;
  float* tot = (float*)(Pm + 64 * 72);
  float* Of = tot + 512;
  const float* GF = (const float*)(p.ws + OFF_GF); const bf16_t* VH = (const bf16_t*)(p.ws + OFF_VH);
  const bf16_t* QH = (const bf16_t*)(p.ws + OFF_QH); const bf16_t* GG = (const bf16_t*)(p.ws + OFF_GG);
  const bf16_t* ST = (const bf16_t*)(p.ws + OFF_ST); bf16_t* AB = (bf16_t*)(p.ws + OFF_AB);
  const int ch = tid & 127, part = tid >> 7;
  for (int item = blockIdx.x; item < (T / 64) * 4; item += gridDim.x) {
    const int h = item & 3, cgl = item >> 2, t0 = cgl * 64;
    f32x4 acc[4];
#pragma unroll
    for (int i = 0; i < 4; ++i) acc[i] = (f32x4){0.f, 0.f, 0.f, 0.f};
    { unsigned short vv[16];
#pragma unroll
      for (int i = 0; i < 16; ++i) vv[i] = VH[(size_t)(t0 + part * 16 + i) * 512 + h * 128 + ch];
      u32x4 w0, w1;
#pragma unroll
      for (int i = 0; i < 4; ++i) { w0[i] = (unsigned)vv[2 * i] | ((unsigned)vv[2 * i + 1] << 16); w1[i] = (unsigned)vv[8 + 2 * i] | ((unsigned)vv[8 + 2 * i + 1] << 16); }
      *(u32x4*)(VT + ch * 72 + part * 16) = w0; *(u32x4*)(VT + ch * 72 + part * 16 + 8) = w1; }
#pragma unroll 1
    for (int d = 0; d < 2; ++d) {
      float g[16], pl[16]; unsigned short qq[16]; float run = 0.f;
#pragma unroll
      for (int i = 0; i < 16; ++i) g[i] = GF[(size_t)(t0 + part * 16 + i) * 1024 + d * 512 + h * 128 + ch];
#pragma unroll
      for (int i = 0; i < 16; ++i) qq[i] = QH[(size_t)(t0 + part * 16 + i) * 512 + h * 128 + ch];
#pragma unroll
      for (int i = 0; i < 16; ++i) { pl[i] = run; run += g[i]; }
      const float lt = run;
      tot[part * 128 + ch] = lt;
      __syncthreads();
      const float t0s = tot[ch], t1s = tot[128 + ch], t2s = tot[256 + ch], t3s = tot[384 + ch];
      const float before = (part > 0 ? t0s : 0.f) + (part > 1 ? t1s : 0.f) + (part > 2 ? t2s : 0.f);
      const float after = (part < 1 ? t1s : 0.f) + (part < 2 ? t2s : 0.f) + (part < 3 ? t3s : 0.f);
      const float cref = d == 0 ? (t0s + t1s) : (t2s + t3s);
#pragma unroll
      for (int i = 0; i < 16; ++i) { const int tok = part * 16 + i;
        const float b = d == 0 ? before + pl[i] + g[i] : after + (lt - pl[i]);
        const float q = bf2f(qq[i]); const float k = 1.f - fexp(g[i]);
        QT[tok * 136 + ch] = f2bf(q * fexp(b - cref)); KT2[tok * 136 + ch] = f2bf(k * fexp(cref - b)); QHt[tok * 136 + ch] = f2bf(q * fexp(b)); }
      __syncthreads();
      { const int rb = wid >> 1;
#pragma unroll
        for (int cbi = 0; cbi < 2; ++cbi) { const int cb = (wid & 1) * 2 + cbi; f32x4 a = {0.f, 0.f, 0.f, 0.f};
#pragma unroll
          for (int ks = 0; ks < 4; ++ks) { const bf16x8 A = *(const bf16x8*)(QT + (rb * 16 + fr) * 136 + ks * 32 + fq * 8), B = *(const bf16x8*)(KT2 + (cb * 16 + fr) * 136 + ks * 32 + fq * 8); a = mfma16(A, B, a); }
#pragma unroll
          for (int j = 0; j < 4; ++j) { const int t = rb * 16 + fq * 4 + j, s = cb * 16 + fr; const bool keep = d == 0 ? (s <= t) : (s >= t);
            Pm[t * 72 + s] = f2bf(keep ? a[j] : 0.f); } } }
      __syncthreads();
      { const bf16_t* S = ST + ((size_t)(cgl * 4 + h) * 2 + d) * 16384;
        bf16x8 Bs[4];
#pragma unroll
        for (int ks = 0; ks < 4; ++ks) { const int q = 4 * ks + fq;
          const bf16_t* e1 = S + (((q >> 1) * 8 + wid) * 64 + (2 * (q & 1)) * 16 + fr) * 4;
          const u32x2 lo = *(const u32x2*)e1, hi = *(const u32x2*)(e1 + 64);
          u32x4 w4 = {lo[0], lo[1], hi[0], hi[1]}; Bs[ks] = *reinterpret_cast<bf16x8*>(&w4); }
        bf16x8 Bv[2];
#pragma unroll
        for (int ks = 0; ks < 2; ++ks) Bv[ks] = *(const bf16x8*)(VT + (wid * 16 + fr) * 72 + ks * 32 + fq * 8);
#pragma unroll
        for (int rbb = 0; rbb < 4; ++rbb) {
#pragma unroll
          for (int ks = 0; ks < 2; ++ks) { const bf16x8 A = *(const bf16x8*)(Pm + (rbb * 16 + fr) * 72 + ks * 32 + fq * 8); acc[rbb] = mfma16(A, Bv[ks], acc[rbb]); }
#pragma unroll
          for (int ks = 0; ks < 4; ++ks) { const bf16x8 A = *(const bf16x8*)(QHt + (rbb * 16 + fr) * 136 + ks * 32 + fq * 8); acc[rbb] = mfma16(A, Bs[ks], acc[rbb]); } } }
      __syncthreads();
    }
#pragma unroll
    for (int rbb = 0; rbb < 4; ++rbb)
#pragma unroll
      for (int j = 0; j < 4; ++j) Of[(rbb * 16 + fq * 4 + j) * 132 + wid * 16 + fr] = acc[rbb][j];
    __syncthreads();
    { const int tok = tid >> 3, c0 = (tid & 7) * 16; float v[16]; float ss = 0.f;
#pragma unroll
      for (int i = 0; i < 16; ++i) { v[i] = Of[tok * 132 + c0 + i]; ss += v[i] * v[i]; }
      ss += __shfl_xor(ss, 1, 64); ss += __shfl_xor(ss, 2, 64); ss += __shfl_xor(ss, 4, 64);
      const float rs = rsqrtf(ss * (1.f / 128.f) + EPS);
      const u32x4 g0 = *(const u32x4*)(GG + (size_t)(t0 + tok) * 512 + h * 128 + c0), g1 = *(const u32x4*)(GG + (size_t)(t0 + tok) * 512 + h * 128 + c0 + 8);
      const float* gw = p.gnorm + l * 128 + c0;
      float o[16];
#pragma unroll
      for (int i = 0; i < 4; ++i) { o[2 * i] = v[2 * i] * rs * gw[2 * i] * bflo(g0[i]); o[2 * i + 1] = v[2 * i + 1] * rs * gw[2 * i + 1] * bfhi(g0[i]);
        o[8 + 2 * i] = v[8 + 2 * i] * rs * gw[8 + 2 * i] * bflo(g1[i]); o[8 + 2 * i + 1] = v[8 + 2 * i + 1] * rs * gw[8 + 2 * i + 1] * bfhi(g1[i]); }
      u32x4 w0, w1;
#pragma unroll
      for (int i = 0; i < 4; ++i) { w0[i] = cvtpk(o[2 * i], o[2 * i + 1]); w1[i] = cvtpk(o[8 + 2 * i], o[8 + 2 * i + 1]); }
      bf16_t* op = AB + (size_t)(t0 + tok) * 1024 + h * 128 + c0;
      *(u32x4*)op = w0; *(u32x4*)(op + 8) = w1; }
    __syncthreads();
  }
}

constexpr int SHM_V = 64 * 128 * 2, SHM_K = 64 * 128 * 2;
#define KSWZ(row, colB) ((row) * 256 + ((colB) ^ (((row) & 7) << 4)))
#define SBAR() __builtin_amdgcn_sched_barrier(0)
__device__ __forceinline__ int crow(int r, int hi) { return (r & 3) + 8 * (r >> 2) + 4 * hi; }
__device__ __forceinline__ void partialSM(f32x16& p0, f32x16& p1, float& m_reg, float& mn, float& alpha) {
  constexpr float C = 1.4426950408889634f; constexpr float THR = 8.f;
  float pmax = p0[0];
#pragma unroll
  for (int r = 1; r < 16; ++r) pmax = fmaxf(pmax, p0[r]);
#pragma unroll
  for (int r = 0; r < 16; ++r) pmax = fmaxf(pmax, p1[r]);
  { auto rr = __builtin_amdgcn_permlane32_swap(__float_as_uint(pmax), __float_as_uint(pmax), false, false);
    pmax = fmaxf(__uint_as_float(rr[0]), __uint_as_float(rr[1])); }
  if (__builtin_expect(__all(pmax - m_reg <= THR), 1)) { mn = m_reg; alpha = 1.f; }
  else { mn = fmaxf(m_reg, pmax); alpha = __builtin_amdgcn_exp2f((m_reg - mn) * C); m_reg = mn; }
  const float mnC = -mn * C;
#pragma unroll
  for (int r = 0; r < 16; ++r) p0[r] = __builtin_amdgcn_exp2f(fmaf(p0[r], C, mnC));
#pragma unroll
  for (int r = 0; r < 16; ++r) p1[r] = __builtin_amdgcn_exp2f(fmaf(p1[r], C, mnC));
}
__device__ __forceinline__ void finishSM(f32x16& p0, f32x16& p1, float alpha, float& l_reg, bf16x8& pa0, bf16x8& pa1, bf16x8& pa2, bf16x8& pa3) {
  float ps = 0;
#pragma unroll
  for (int r = 0; r < 16; ++r) ps += p0[r];
#pragma unroll
  for (int r = 0; r < 16; ++r) ps += p1[r];
  { auto rr = __builtin_amdgcn_permlane32_swap(__float_as_uint(ps), __float_as_uint(ps), false, false);
    ps = __uint_as_float(rr[0]) + __uint_as_float(rr[1]); }
  l_reg = l_reg * alpha + ps;
#define PK4(P, BASE, OUT) do { unsigned a0 = cvtpk(P[BASE + 0], P[BASE + 1]), a1 = cvtpk(P[BASE + 2], P[BASE + 3]);   \
    unsigned b0 = cvtpk(P[BASE + 4], P[BASE + 5]), b1 = cvtpk(P[BASE + 6], P[BASE + 7]);                              \
    auto r0 = __builtin_amdgcn_permlane32_swap(a0, b0, false, false); auto r1 = __builtin_amdgcn_permlane32_swap(a1, b1, false, false); \
    u32x4 w = {r0[0], r1[0], r0[1], r1[1]}; OUT = *reinterpret_cast<bf16x8*>(&w); } while (0)
  PK4(p0, 0, pa0); PK4(p0, 8, pa1); PK4(p1, 0, pa2); PK4(p1, 8, pa3);
#undef PK4
}
template <int H>
__device__ __forceinline__ void qkt_half(f32x16& p0, f32x16& p1, const char* Ks, const bf16x8* qr, int r32, int hi) {
#pragma unroll
  for (int r = 0; r < 16; ++r) { p0[r] = 0.f; p1[r] = 0.f; }
#pragma unroll
  for (int d0 = 0; d0 < 4; ++d0) { const int cb = ((H * 4 + d0) * 16 + hi * 8) * 2;
    const bf16x8 b0 = *reinterpret_cast<const bf16x8*>(Ks + KSWZ(r32, cb));
    const bf16x8 b1 = *reinterpret_cast<const bf16x8*>(Ks + KSWZ(32 + r32, cb));
    p0 = __builtin_amdgcn_mfma_f32_32x32x16_bf16(b0, qr[H * 4 + d0], p0, 0, 0, 0);
    p1 = __builtin_amdgcn_mfma_f32_32x32x16_bf16(b1, qr[H * 4 + d0], p1, 0, 0, 0); }
}
__device__ __forceinline__ int v_st(int k, int c) { const int kk = (k & ~0xC) | ((k & 4) << 1) | ((k & 8) >> 1); return ((kk >> 3) * 4 + (c >> 5)) * 512 + ((kk & 7) * 32 + (c & 31)) * 2; }
__device__ __forceinline__ int v_rd_base(int lane) { return ((lane & 3) << 3) | (((lane >> 2) & 3) << 6) | (((lane >> 4) & 1) << 5) | (((lane >> 5) & 1) << 8); }
constexpr int v_rd_off(int d0, int ks, int half) { return d0 * 512 + ks * 4096 + half * 2048; }
template <int OFF> __device__ __forceinline__ s16x4 tr_read(int vb) {
  s16x4 r; asm volatile("ds_read_b64_tr_b16 %0, %1 offset:%2" : "=&v"(r) : "v"(vb), "i"(OFF) : "memory"); return r;
}
struct VB8 { s16x4 l0, h0, l1, h1, l2, h2, l3, h3; };
template <int D0> __device__ __forceinline__ void pv_rd(VB8& r, int vb) {
  r.l0 = tr_read<v_rd_off(D0, 0, 0)>(vb); r.h0 = tr_read<v_rd_off(D0, 0, 1)>(vb); r.l1 = tr_read<v_rd_off(D0, 1, 0)>(vb); r.h1 = tr_read<v_rd_off(D0, 1, 1)>(vb);
  r.l2 = tr_read<v_rd_off(D0, 2, 0)>(vb); r.h2 = tr_read<v_rd_off(D0, 2, 1)>(vb); r.l3 = tr_read<v_rd_off(D0, 3, 0)>(vb); r.h3 = tr_read<v_rd_off(D0, 3, 1)>(vb);
}
__device__ __forceinline__ void pv_mm(f32x16& od, const VB8& r, bf16x8 pa0, bf16x8 pa1, bf16x8 pa2, bf16x8 pa3) {
#define PK(L, H) (bf16x8){L[0], L[1], L[2], L[3], H[0], H[1], H[2], H[3]}
  od = __builtin_amdgcn_mfma_f32_32x32x16_bf16(pa0, PK(r.l0, r.h0), od, 0, 0, 0);
  od = __builtin_amdgcn_mfma_f32_32x32x16_bf16(pa1, PK(r.l1, r.h1), od, 0, 0, 0);
  od = __builtin_amdgcn_mfma_f32_32x32x16_bf16(pa2, PK(r.l2, r.h2), od, 0, 0, 0);
  od = __builtin_amdgcn_mfma_f32_32x32x16_bf16(pa3, PK(r.l3, r.h3), od, 0, 0, 0);
#undef PK
}
__device__ __forceinline__ void pv_d0(f32x16* o, int vb, bf16x8 pa0, bf16x8 pa1, bf16x8 pa2, bf16x8 pa3) {
  VB8 a, b;
  pv_rd<0>(a, vb); pv_rd<1>(b, vb);
  asm volatile("s_waitcnt lgkmcnt(8)" ::: "memory"); SBAR(); pv_mm(o[0], a, pa0, pa1, pa2, pa3); SBAR();
  pv_rd<2>(a, vb);
  asm volatile("s_waitcnt lgkmcnt(8)" ::: "memory"); SBAR(); pv_mm(o[1], b, pa0, pa1, pa2, pa3); SBAR();
  pv_rd<3>(b, vb);
  asm volatile("s_waitcnt lgkmcnt(8)" ::: "memory"); SBAR(); pv_mm(o[2], a, pa0, pa1, pa2, pa3); SBAR();
  asm volatile("s_waitcnt lgkmcnt(0)" ::: "memory"); SBAR(); pv_mm(o[3], b, pa0, pa1, pa2, pa3);
}

__device__ void attn_phase(const Params& p, int l, int L, unsigned char* smem, int T) {
  const int tid = otid(), wid = tid >> 6, lane = tid & 63, r32 = lane & 31, hi = lane >> 5;
  char* lds = (char*)smem;
  char* V_lds = lds; char* K_lds = lds + 3 * SHM_V;
  float* wsf = (float*)(lds + 3 * SHM_V + 2 * SHM_K) + wid * 128; float* li1 = wsf; float* al_l = wsf + 64;
  const bf16_t* QD = (const bf16_t*)(p.ws + OFF_QD); const bf16_t* KD = (const bf16_t*)(p.ws + OFF_KD); const bf16_t* VD = (const bf16_t*)(p.ws + OFF_VD);
  bf16_t* AB = (bf16_t*)(p.ws + OFF_AB);
  const float lam = ((const float*)(p.ws + OFF_LAM))[l], oml = ((const float*)(p.ws + OFF_LAM))[8 + l];
  const int nq = L / 256, NT = L / 64;
  const int vb0 = (int)(uintptr_t)V_lds + v_rd_base(lane);
  const int wid_u = __builtin_amdgcn_readfirstlane(wid);
  LAS unsigned char* ldsV = (LAS unsigned char*)smem; LAS unsigned char* ldsK = ldsV + 3 * SHM_V;
  const int half = wid_u >> 2;
  unsigned kso[2], vso[2];
#pragma unroll
  for (int i = 0; i < 2; ++i) { const int b = i * 8192 + tid * 16;
    { const int row = b >> 8, cphys = b & 255, colB = cphys ^ ((row & 7) << 4); kso[i] = (unsigned)(row * 1024 + colB); }
    { const int sub = b >> 9, kkhi = sub >> 2, chi = sub & 3, within = b & 511, kklo = within >> 6, clo = (within & 63) >> 1;
      const int kk = kkhi * 8 + kklo, k = (kk & ~0xC) | ((kk & 4) << 1) | ((kk & 8) >> 1); vso[i] = (unsigned)(k * 1024 + (chi * 32 + clo) * 2); } }
  const int nitems = (T / 256) * 4;
  for (int it = blockIdx.x; it < nitems; it += gridDim.x) {
    const int pair = (it & 7) * 4 + (it >> 3) / nq, qb = (it >> 3) % nq;
    const int s = pair >> 2, h = pair & 3;
    const size_t rowbase = (size_t)s * L;
    const bf16_t* Qb = QD + (rowbase + (size_t)qb * 256) * 512 + h * 128;
    const bf16_t* Kh = KD + rowbase * 512 + h * 128; const bf16_t* Vh = VD + rowbase * 512 + h * 128;
#pragma unroll 1
    for (int mp = 0; mp < 2; ++mp) {
      float m_reg = -1e30f, l_reg = 0.f;
      f32x16 o[4];
#pragma unroll
      for (int dd = 0; dd < 4; ++dd)
#pragma unroll
        for (int r = 0; r < 16; ++r) o[dd][r] = 0.f;
      bf16x8 qr[4];
      { const int t2 = otid(); const unsigned qoff = (unsigned)(((t2 >> 6) * 32 + (t2 & 31)) * 512 + ((t2 >> 5) & 1) * 8 + mp * 64) * 2u;
#pragma unroll
        for (int d0 = 0; d0 < 4; ++d0) qr[d0] = *(const bf16x8*)((const char*)Qb + qoff + d0 * 32); }
#define SDMA(k0, kb, vb) do { const char* kb_ = (const char*)Kh + (size_t)(k0) * 1024; const char* vb_ = (const char*)Vh + (size_t)(k0) * 1024; \
    _Pragma("unroll") for (int i_ = 0; i_ < 2; ++i_) { \
      __builtin_amdgcn_global_load_lds((const unsigned*)(kb_ + kso[i_]), (LAS unsigned*)(ldsK + (kb) * SHM_K + i_ * 8192 + wid_u * 1024), 16, 0, 0); \
      __builtin_amdgcn_global_load_lds((const unsigned*)(vb_ + vso[i_]), (LAS unsigned*)(ldsV + (vb) * SHM_V + i_ * 8192 + wid_u * 1024), 16, 0, 0); } } while (0)
      SDMA(0, 0, 0); asm volatile("s_waitcnt vmcnt(0)" ::: "memory"); __syncthreads();
      bf16x8 pa0, pa1, pa2, pa3;
      int vcur = 0, vprev = 2;
      for (int j = 0; j < NT; ++j) {
        const int cur = j & 1; const int vnext = vcur == 2 ? 0 : vcur + 1;
        if (j + 1 < NT) SDMA((j + 1) * 64, cur ^ 1, vnext);
        if (half == 1 && j > 0) pv_d0(o, vb0 + vprev * SHM_V, pa0, pa1, pa2, pa3);
        f32x16 p0, p1; float mn, al;
        qkt_half<0>(p0, p1, K_lds + cur * SHM_K + mp * 128, qr, r32, hi);
        partialSM(p0, p1, m_reg, mn, al);
        if (__any(al < 1.f)) { if (hi == 0) al_l[r32] = al; asm volatile("s_waitcnt lgkmcnt(0)" ::: "memory");
#pragma unroll
          for (int r = 0; r < 16; ++r) { const float av = al_l[crow(r, hi)];
#pragma unroll
            for (int dd = 0; dd < 4; ++dd) o[dd][r] *= av; } }
        finishSM(p0, p1, al, l_reg, pa0, pa1, pa2, pa3);
        if (half == 0) pv_d0(o, vb0 + vcur * SHM_V, pa0, pa1, pa2, pa3);
        asm volatile("s_waitcnt vmcnt(0)" ::: "memory");
        __syncthreads();
        vprev = vcur; vcur = vnext;
      }
      if (half == 1) pv_d0(o, vb0 + vprev * SHM_V, pa0, pa1, pa2, pa3);
      __syncthreads();
#undef SDMA
      if (hi == 0) li1[r32] = l_reg;
      asm volatile("s_waitcnt lgkmcnt(0)" ::: "memory");
      const int t3 = otid();
      f32x4* OS = (f32x4*)(p.ws + OFF_OS + (size_t)obid() * (512 * 256)) + (unsigned)t3;
      if (mp == 0) {
#pragma unroll
        for (int r4 = 0; r4 < 4; ++r4) { float il[4];
#pragma unroll
          for (int q = 0; q < 4; ++q) il[q] = __builtin_amdgcn_rcpf(li1[crow(r4 * 4 + q, hi)]);
#pragma unroll
          for (int dd = 0; dd < 4; ++dd) OS[(dd * 4 + r4) * 512] = (f32x4){o[dd][r4 * 4] * il[0], o[dd][r4 * 4 + 1] * il[1], o[dd][r4 * 4 + 2] * il[2], o[dd][r4 * 4 + 3] * il[3]}; }
      } else {
        const float* sw = p.subln + l * 128;
        const float sw0 = sw[r32], sw1 = sw[32 + r32], sw2 = sw[64 + r32], sw3 = sw[96 + r32];
        bf16_t* Ow = AB + (rowbase + (size_t)qb * 256) * 1024 + 512 + h * 128 + (unsigned)((t3 >> 6) * 32 * 1024 + (t3 & 31));
#pragma unroll
        for (int r4 = 0; r4 < 4; ++r4) { const f32x4 a0 = OS[r4 * 512], a1 = OS[(4 + r4) * 512], a2 = OS[(8 + r4) * 512], a3 = OS[(12 + r4) * 512];
#pragma unroll
          for (int q = 0; q < 4; ++q) { const int r = r4 * 4 + q; const int orow = crow(r, hi);
            const float i2 = lam * __builtin_amdgcn_rcpf(li1[orow]);
            const float v0 = a0[q] - o[0][r] * i2, v1 = a1[q] - o[1][r] * i2, v2 = a2[q] - o[2][r] * i2, v3 = a3[q] - o[3][r] * i2;
            float ss = v0 * v0 + v1 * v1 + v2 * v2 + v3 * v3;
            ss += __shfl_xor(ss, 1, 64); ss += __shfl_xor(ss, 2, 64); ss += __shfl_xor(ss, 4, 64); ss += __shfl_xor(ss, 8, 64); ss += __shfl_xor(ss, 16, 64);
            const float rs = rsqrtf(ss * (1.f / 128.f) + EPS) * oml;
            bf16_t* op = Ow + (size_t)orow * 1024;
            op[0] = f2bf(v0 * rs * sw0); op[32] = f2bf(v1 * rs * sw1); op[64] = f2bf(v2 * rs * sw2); op[96] = f2bf(v3 * rs * sw3); } }
      }
    }
  }
}

__device__ void init_sb(const Params& p, int sb) {
  const int T = sb == 0 ? 16384 : 32768, rowoff = sb == 0 ? 0 : 16384 + (sb - 1) * 32768;
  const float* xin = sb == 0 ? p.x_prompt : p.x_sample + (size_t)(sb - 1) * 32768 * 1024;
  rowwise_phase(xin, p.out + (size_t)rowoff * 1024, nullptr, nullptr, p.n_mix_pre, true, (bf16_t*)(p.ws + OFF_H), 1024, 0, nullptr, T, false);
}
__device__ __forceinline__ void run_step(const Params& p, int step, unsigned char* smem) {
  if (step == 0) { prep_phase(p, smem); init_sb(p, 0); return; }
  const int s_ = step - 1, sb = s_ / SPB, r = s_ % SPB;
  const int T = sb == 0 ? 16384 : 32768, rowoff = sb == 0 ? 0 : 16384 + (sb - 1) * 32768;
  const int L = sb == 0 ? 2048 : 4096, nseq = T / L, nc = L / 64;
  float* xres = p.out + (size_t)rowoff * 1024;
  unsigned char* ws = p.ws;
  const int l = r / PPL, seq_ = r % PPL;
  const int ph = seq_;
  unsigned char* wl = ws + (size_t)l * SZ_WL;
  LAS unsigned char* lds = (LAS unsigned char*)smem;
  pg8::StaticOrder S;
  switch (ph) {
    case 0: { pg8::Gemm g{(const bf16_t*)(ws + OFF_H), (const bf16_t*)(wl + OFF_WIN), 1024, 1024, T, INC, 1024};
      S.init(g.M, g.N, (int)gridDim.x, (int)blockIdx.x); EpiWin E{ws, l, L - 1}; pg8::gemm_phase<EpiWin, false>(lds, g, S, E, -1); } break;
    case 1: attn_phase(p, l, L, smem, T); __syncthreads(); hg_delta_phase(p, smem, T); break;
    case 2: hg_scan_phase(p, nseq, nc); break;
    case 3: hg_out_phase(p, l, smem, T); break;
    case 4: {
      pg8::Gemm g{(const bf16_t*)(ws + OFF_AB), (const bf16_t*)(wl + OFF_WAB), 1024, 1024, T, 1024, 1024};
      S.init(g.M, g.N, (int)gridDim.x, (int)blockIdx.x);
      EpiMerge E{(const bf16_t*)(ws + OFF_GA), (const bf16_t*)(ws + OFF_GB), (bf16_t*)(ws + OFF_M)};
      pg8::gemm_phase<EpiMerge, true>(lds, g, S, E, 8); } break;
    case 5: case 7: case 9: {
      pg8::Gemm g; EpiPlain E;
      if (ph == 5) { g = pg8::Gemm{(const bf16_t*)(ws + OFF_M), (const bf16_t*)(wl + OFF_WOUT), 1024, 1024, T, 1024, 1024}; E = EpiPlain{(bf16_t*)(ws + OFF_MO), 1024}; }
      else if (ph == 7) { g = pg8::Gemm{(const bf16_t*)(ws + OFF_H), (const bf16_t*)(wl + OFF_WUP), 1024, 1024, T, FF2, 1024}; E = EpiPlain{(bf16_t*)(ws + OFF_U), FF2}; }
      else { g = pg8::Gemm{(const bf16_t*)(ws + OFF_ACT), (const bf16_t*)(wl + OFF_WDOWN), FF, FF, T, 1024, FF}; E = EpiPlain{(bf16_t*)(ws + OFF_MO), 1024}; }
      S.init(g.M, g.N, (int)gridDim.x, (int)blockIdx.x); pg8::gemm_phase<EpiPlain, false>(lds, g, S, E, -1); } break;
    case 6: rowwise_phase(nullptr, xres, (const bf16_t*)(ws + OFF_MO), p.n_mix_post + l * 1024, p.n_ffn_pre + l * 1024, true, (bf16_t*)(ws + OFF_H), 1024, 0, nullptr, T, false); break;
    case 8: conv_phase((const bf16_t*)(ws + OFF_U), p.conv_w + (size_t)l * 3 * FF2, p.conv_b + (size_t)l * FF2, (bf16_t*)(ws + OFF_ACT), L - 1, T); break;
    case 10: { const float* pp = sb == 0 ? p.p_prompt + (size_t)l * 16384 * 256 : p.p_sample + ((size_t)l * 65536 + (size_t)(sb - 1) * 32768) * 256;
      rowwise_phase(nullptr, xres, (const bf16_t*)(ws + OFF_MO), p.n_ffn_post + l * 1024, nullptr, true, (bf16_t*)(ws + OFF_AP), 1280, 256, pp, T, false); } break;
    case 11: { pg8::Gemm g{(const bf16_t*)(ws + OFF_AP), (const bf16_t*)(wl + OFF_WPG), 1280, 1280, T, 1024, 1280};
      S.init(g.M, g.N, (int)gridDim.x, (int)blockIdx.x); EpiPle E{(bf16_t*)(ws + OFF_M)}; pg8::gemm_phase<EpiPle, true>(lds, g, S, E, 4); } break;
    case 12: rowwise_phase(nullptr, xres, (const bf16_t*)(ws + OFF_M), p.n_ple + l * 1024, l < 3 ? p.n_mix_pre + (l + 1) * 1024 : nullptr, l < 3, (bf16_t*)(ws + OFF_H), 1024, 0, nullptr, T, l == 3); if (l == NL - 1 && sb + 1 < NSB) init_sb(p, sb + 1); break;
    default: break;
  }
}


#define XB_TMO      128
#define XB_XCNT(j)  (256  + 64 * (j))
#define XB_XSUB(j)  (1280 + 64 * (j))
#define XB_XGEN(j)  (2304 + 64 * (j))
#define XB_TOP      3328
#define XB_TOPGEN   3392
#define XCD_BAR_WORDS 3456
#define XB_SPIN_CAP (1u << 18)
__device__ __forceinline__ unsigned xb_ld(unsigned* p)              { return __hip_atomic_load(p, __ATOMIC_RELAXED, __HIP_MEMORY_SCOPE_AGENT); }
__device__ __forceinline__ unsigned xb_add(unsigned* p, unsigned v) { return __hip_atomic_fetch_add(p, v, __ATOMIC_RELAXED, __HIP_MEMORY_SCOPE_AGENT); }
__device__ __forceinline__ unsigned xb_xcc_id() { return (unsigned)__builtin_amdgcn_s_getreg((3 << 11) | 20) & 0xFu; }
#define XB_SPIN(cond, bar) do { unsigned _sp = 0; while (cond) { __builtin_amdgcn_s_sleep(1); \
    if ((++_sp & 255u) == 0u) { if (xb_ld(&(bar)[XB_TMO])) break; if (_sp > XB_SPIN_CAP) { atomicAdd(&(bar)[XB_TMO], 1u); break; } } } } while (0)
__device__ __forceinline__ void xcd_barrier_complete(unsigned* bar, unsigned x, unsigned& nloc, unsigned& nx) {
  const unsigned G = gridDim.x * gridDim.y * gridDim.z;
  unsigned sum, cnt, mine, sp = 0u;
  for (;;) {
    sum = 0u; cnt = 0u; mine = 0u;
#pragma unroll
    for (unsigned j = 0; j < 16; ++j) { const unsigned c = xb_ld(&bar[XB_XCNT(j)]); sum += c; cnt += (c > 0u) ? 1u : 0u; mine = (j == x) ? c : mine; }
    if (sum == G) break;
    __builtin_amdgcn_s_sleep(1);
    if ((++sp & 255u) == 0u) { if (xb_ld(&bar[XB_TMO])) break; if (sp > XB_SPIN_CAP) { atomicAdd(&bar[XB_TMO], 1u); break; } }
  }
  nloc = mine > 0u ? mine : 1u; nx = cnt > 0u ? cnt : 1u;
}
__device__ __forceinline__ void xcd_barrier(unsigned* bar, volatile LAS unsigned* st) {
  asm volatile("s_waitcnt vmcnt(0)" ::: "memory");
  __syncthreads();
  if (threadIdx.x == 0) {
    const unsigned x = xb_xcc_id();
    __builtin_amdgcn_s_waitcnt(0);
    unsigned nloc = st[0], nx = st[1];
    if (nloc == 0u) { xcd_barrier_complete(bar, x, nloc, nx); st[0] = nloc; st[1] = nx; }
    const unsigned old = xb_add(&bar[XB_XSUB(x)], 1u);
    const unsigned gen = old / nloc;
    if (old + 1u == (gen + 1u) * nloc) {
      __builtin_amdgcn_fence(__ATOMIC_RELEASE, "agent");
      asm volatile("s_waitcnt vmcnt(0)" ::: "memory");
      const unsigned og = xb_add(&bar[XB_TOP], 1u);
      const unsigned tg = og / nx;
      if (og + 1u == (tg + 1u) * nx) xb_add(&bar[XB_TOPGEN], 1u);
      else XB_SPIN(xb_ld(&bar[XB_TOPGEN]) == tg, bar);
      __builtin_amdgcn_fence(__ATOMIC_ACQUIRE, "agent");
      xb_add(&bar[XB_XGEN(x)], 1u);
      asm volatile("s_waitcnt vmcnt(0)" ::: "memory");
    } else {
      XB_SPIN(xb_ld(&bar[XB_XGEN(x)]) == gen, bar);
      __builtin_amdgcn_fence(__ATOMIC_ACQUIRE, "agent");
      asm volatile("s_waitcnt vmcnt(0)" ::: "memory");
    }
  }
  __syncthreads();
}

__global__ __launch_bounds__(512, 2) void mega(Params p, int s_begin, int s_end) {
  extern __shared__ __attribute__((aligned(16))) unsigned char smem[];
#if ONE_LAUNCH
  cg::grid_group grid = cg::this_grid();
  volatile LAS unsigned* st = (volatile LAS unsigned*)((LAS unsigned char*)smem + 131072);
  unsigned* bar = (unsigned*)(p.ws + OFF_BAR);
  if (threadIdx.x == 0) { st[0] = 0u; st[1] = 0u; st[2] = 0u; st[3] = 0u; (void)xb_add(&bar[XB_XCNT(xb_xcc_id())], 1u); }
  __syncthreads();
#endif
  for (int step = s_begin; step < s_end; ++step) {
    run_step(p, step, smem);
#if ONE_LAUNCH
    if (step + 1 < s_end) { if (s_end < 0) grid.sync();
      xcd_barrier(bar, st); }
#endif
  }
}

extern "C" void kernel_launch(void* const* d_in, const int* in_sizes, int n_in, void* d_out, int out_size, void* d_ws, size_t ws_size, hipStream_t stream) {
  static int grid = 0;
  if (grid == 0) {
    if (n_in != 23 || ws_size < WS_END || out_size != NTOK * 1024) {
      fprintf(stderr, "kernel_launch: unexpected shapes: n_in %d out %d ws %zu (need %zu)\n", n_in, out_size, ws_size, (size_t)WS_END); grid = -1; return; }
    int dev = 0, cus = 0, per_cu = 0;
    hipGetDevice(&dev); hipDeviceGetAttribute(&cus, hipDeviceAttributeMultiprocessorCount, dev);
    if (hipFuncSetAttribute((const void*)mega, hipFuncAttributeMaxDynamicSharedMemorySize, LDS_BYTES) != hipSuccess) { fprintf(stderr, "kernel_launch: hipFuncSetAttribute failed\n"); grid = -1; return; }
    if (hipOccupancyMaxActiveBlocksPerMultiprocessor(&per_cu, (const void*)mega, 512, LDS_BYTES) != hipSuccess || per_cu < 1) { fprintf(stderr, "kernel_launch: occupancy query gave %d\n", per_cu); per_cu = 1; }
    (void)hipGetLastError();
    grid = cus * per_cu; if (grid > 256) grid = 256;
  }
  if (grid < 0) return;
  Params p{};
  p.x_prompt = (const float*)d_in[0]; p.x_sample = (const float*)d_in[1]; p.p_prompt = (const float*)d_in[2]; p.p_sample = (const float*)d_in[3];
  p.w_in = (const float*)d_in[4]; p.lb_logits = (const float*)d_in[5]; p.gnorm = (const float*)d_in[6]; p.dlam = (const float*)d_in[7]; p.subln = (const float*)d_in[8];
  p.w_a = (const float*)d_in[9]; p.w_b = (const float*)d_in[10]; p.w_out = (const float*)d_in[11]; p.n_mix_pre = (const float*)d_in[12]; p.n_mix_post = (const float*)d_in[13];
  p.w_up = (const float*)d_in[14]; p.conv_w = (const float*)d_in[15]; p.conv_b = (const float*)d_in[16]; p.w_down = (const float*)d_in[17]; p.n_ffn_pre = (const float*)d_in[18]; p.n_ffn_post = (const float*)d_in[19];
  p.w_ple = (const float*)d_in[20]; p.w_pg = (const float*)d_in[21]; p.n_ple = (const float*)d_in[22];
  p.out = (float*)d_out; p.ws = (unsigned char*)d_ws;
#if ONE_LAUNCH
  if (hipMemsetAsync((char*)d_ws + OFF_BAR, 0, XCD_BAR_WORDS * 4, stream) != hipSuccess) { fprintf(stderr, "kernel_launch: memset of barrier words failed\n"); return; }
  int s0 = 0, s1 = NSTEPS;
  void* args[] = {&p, &s0, &s1};
  hipError_t e = hipLaunchCooperativeKernel((const void*)mega, dim3(grid), dim3(512), args, LDS_BYTES, stream);
  if (e != hipSuccess) fprintf(stderr, "cooperative launch failed: %s (grid %d)\n", hipGetErrorString(e), grid);
#else
  for (int s = 0; s < NSTEPS; ++s) hipLaunchKernelGGL(mega, dim3(grid), dim3(512), LDS_BYTES, stream, p, s, s + 1);
#endif
}
```

```cpp
#include <hip/hip_runtime.h>
#include <hip/hip_cooperative_groups.h>
#include <cstdio>
#include <cstdint>
namespace cg = cooperative_groups;

#ifndef ONE_LAUNCH
#define ONE_LAUNCH 1
#endif

#define LAS __attribute__((address_space(3)))
typedef unsigned short bf16_t;
typedef short bf16x8 __attribute__((ext_vector_type(8)));
typedef short s16x4 __attribute__((ext_vector_type(4)));
typedef float f32x4 __attribute__((ext_vector_type(4)));
typedef float f32x16 __attribute__((ext_vector_type(16)));
typedef unsigned u32x4 __attribute__((ext_vector_type(4)));
typedef unsigned u32x2 __attribute__((ext_vector_type(2)));

constexpr int TMAX = 32768;
constexpr int NSB = 3, NL = 4, INC = 6144, FF = 2816, FF2 = 5632;
constexpr int NTOK = 81920;
constexpr float EPS = 1e-6f;
constexpr size_t SZ_WIN = (size_t)INC * 1024 * 2, SZ_WAB = (size_t)1024 * 1024 * 2, SZ_WOUT = (size_t)1024 * 1024 * 2,
                 SZ_WUP = (size_t)FF2 * 1024 * 2, SZ_WDOWN = (size_t)1024 * FF * 2, SZ_WPG = (size_t)1024 * 1280 * 2;
constexpr size_t OFF_WIN = 0, OFF_WAB = OFF_WIN + SZ_WIN, OFF_WOUT = OFF_WAB + SZ_WAB, OFF_WUP = OFF_WOUT + SZ_WOUT,
                 OFF_WDOWN = OFF_WUP + SZ_WUP, OFF_WPG = OFF_WDOWN + SZ_WDOWN, SZ_WL = OFF_WPG + SZ_WPG;
constexpr size_t OFF_LB = SZ_WL * NL, OFF_LAM = OFF_LB + 16384, OFF_COS = OFF_LAM + 256, OFF_SIN = OFF_COS + 524288;
constexpr size_t TT = (size_t)TMAX;
constexpr size_t OFF_H = OFF_SIN + 524288;
constexpr size_t OFF_QH = OFF_H + TT * 2048, OFF_GF = OFF_QH + TT * 1024, OFF_VH = OFF_GF + TT * 4096, OFF_GG = OFF_VH + TT * 1024,
                 OFF_QD = OFF_GG + TT * 1024, OFF_KD = OFF_QD + TT * 1024, OFF_VD = OFF_KD + TT * 1024, OFF_GA = OFF_VD + TT * 1024,
                 OFF_GB = OFF_GA + TT * 2048, OFF_AB = OFF_GB + TT * 2048, OFF_ST = OFF_AB + TT * 2048, OFF_DC = OFF_ST + TT * 4096,
                 OFF_M = OFF_DC + TT * 64, OFF_MO = OFF_M + TT * 2048, OFF_BAR = OFF_MO + TT * 2048, WS_END = OFF_BAR + 16384;
constexpr size_t OFF_U = OFF_QH, OFF_AP = OFF_QH, OFF_ACT = OFF_AB, OFF_OS = OFF_M;
static_assert(OFF_AB - OFF_QH >= TT * 11264 && OFF_DC - OFF_AB >= TT * 5632 && TT * 2048 >= (size_t)256 * 512 * 256, "alias spans");
constexpr int LDS_BYTES = 135168;
constexpr int PPL = 13;
constexpr int SPB = PPL * NL;
constexpr int NSTEPS = 1 + NSB * SPB;

struct Params {
  const float* x_prompt; const float* x_sample; const float* p_prompt; const float* p_sample;
  const float* w_in; const float* lb_logits; const float* gnorm; const float* dlam; const float* subln;
  const float* w_a; const float* w_b; const float* w_out; const float* n_mix_pre; const float* n_mix_post;
  const float* w_up; const float* conv_w; const float* conv_b; const float* w_down; const float* n_ffn_pre; const float* n_ffn_post;
  const float* w_ple; const float* w_pg; const float* n_ple;
  float* out; unsigned char* ws;
};

typedef __bf16 bf16x2_t __attribute__((ext_vector_type(2)));
typedef float f32x2_t __attribute__((ext_vector_type(2)));
__device__ __forceinline__ unsigned cvtpk(float lo, float hi) { f32x2_t v = {lo, hi}; bf16x2_t b = __builtin_convertvector(v, bf16x2_t); return __builtin_bit_cast(unsigned, b); }
__device__ __forceinline__ float bf2f(unsigned short b) { return __uint_as_float(((unsigned)b) << 16); }
__device__ __forceinline__ float bflo(unsigned w) { return __uint_as_float(w << 16); }
__device__ __forceinline__ float bfhi(unsigned w) { return __uint_as_float(w & 0xffff0000u); }
__device__ __forceinline__ unsigned short f2bf(float f) { return (unsigned short)(cvtpk(f, 0.f) & 0xffffu); }
__device__ __forceinline__ float fexp(float x) { return __builtin_amdgcn_exp2f(x * 1.4426950408889634f); }
__device__ __forceinline__ float sigm(float x) { return __builtin_amdgcn_rcpf(1.f + fexp(-x)); }
__device__ __forceinline__ f32x4 mfma16(bf16x8 a, bf16x8 b, f32x4 c) { return __builtin_amdgcn_mfma_f32_16x16x32_bf16(a, b, c, 0, 0, 0); }
__device__ __forceinline__ int otid() { int t = threadIdx.x; asm volatile("" : "+v"(t)); return t; }
__device__ __forceinline__ int obid() { int t = blockIdx.x; asm volatile("" : "+s"(t)); return t; }
__device__ __forceinline__ float wave_sum(float v) {
#pragma unroll
  for (int o = 32; o >= 1; o >>= 1) v += __shfl_xor(v, o, 64);
  return v;
}

namespace pg8 {
constexpr int BM = 256, BK = 64, HALF = 128, HTB = HALF * BK * 2, STAGE_BYTES = 8 * HTB, NXCD = 8, WGM = 8;
__device__ __forceinline__ int lds_byte(int r, int c) { const int st = (r >> 4) * 2 + (c >> 5), rr = r & 15, cc = c & 31, ob = rr * 64 + cc * 2; return st * 1024 + (ob ^ (((ob >> 9) & 1) << 5)); }
__device__ __forceinline__ void stage_rc(int b, int& R, int& C) { const int st = b / 1024, sb = b % 1024, swz = sb ^ (((sb >> 9) & 1) << 5); R = (st >> 1) * 16 + swz / 64; C = (st & 1) * 32 + (swz % 64) / 2; }
struct Unit { int pm, pn; };
struct Gemm { const bf16_t* A; const bf16_t* Bt; int lda, ldb, M, N, K; };
struct StaticOrder {
  int nM, nN, nwg, G, c;
  __device__ void init(int M, int N, int G_, int c_) { nM = M / BM; nN = N / BM; nwg = nM * nN; G = G_; c = c_; }
  __device__ bool next(int i, Unit& u) const {
    const long L = (long)i * G + c; if (L >= nwg) return false;
    int wgid = (int)L; { const int q = nwg / NXCD, r = nwg % NXCD, xcd = wgid % NXCD, off = wgid / NXCD; wgid = (xcd < r ? xcd * (q + 1) : r * (q + 1) + (xcd - r) * q) + off; }
    const int nig = WGM * nN, gid = wgid / nig, fm = gid * WGM, gsz = (nM - fm) < WGM ? (nM - fm) : WGM;
    u.pm = fm + ((wgid % nig) % gsz); u.pn = (wgid % nig) / gsz; return true;
  }
};

template <class Epi, bool HOOK>
__device__ __forceinline__ void gemm_phase(LAS unsigned char* lds, const Gemm g, const StaticOrder& S, const Epi& E, const int hook_t) {
  const int tid = otid(), wid = __builtin_amdgcn_readfirstlane(tid >> 6), lane = tid & 63, wr = wid >> 2, wc = wid & 3, fr = lane & 15, fq = lane >> 4;
  const int K = g.K, nt = K / BK;
  unsigned voffA[2], voffB[2];
#pragma unroll
  for (int i = 0; i < 2; ++i) { int R, C; stage_rc(tid * 16 + i * 8192, R, C);
    voffA[i] = (unsigned)(R * g.lda + C) * 2u; voffB[i] = (unsigned)(R * g.ldb + C) * 2u; }
  const size_t kstep = (size_t)(BK * 2);
  const size_t hstepA = (size_t)HALF * g.lda * 2, hstepB = (size_t)HALF * g.ldb * 2;
  const size_t tstepA = 2 * hstepA, tstepB = 2 * hstepB;
  const unsigned ldsw = (unsigned)wid * 1024u;
  const int aoff = lds_byte(wr * 64 + fr, fq * 8), boff = lds_byte(wc * 32 + fr, fq * 8);
#define PG8_SA(b, h) (((b) * 2 + (h)) * HTB)
#define PG8_SB(b, h) ((4 + (b) * 2 + (h)) * HTB)
#define PG8_STAGE(bufoff, gbase, voff) do { _Pragma("unroll") for (int _i = 0; _i < 2; ++_i) \
    __builtin_amdgcn_global_load_lds((const unsigned*)((const char*)(gbase) + (voff)[_i]), (LAS unsigned*)(lds + (bufoff) + ldsw + _i * 8192), 16, 0, 0); } while (0)
#define PG8_LDA(dst, b, h) do { _Pragma("unroll") for (int m = 0; m < 4; ++m) _Pragma("unroll") for (int k = 0; k < 2; ++k) dst[m][k] = *(const LAS bf16x8*)(lds + PG8_SA(b, h) + aoff + m * 2048 + k * 1024); } while (0)
#define PG8_LDB(dst, b, h) do { _Pragma("unroll") for (int n = 0; n < 2; ++n) _Pragma("unroll") for (int k = 0; k < 2; ++k) dst[n][k] = *(const LAS bf16x8*)(lds + PG8_SB(b, h) + boff + n * 2048 + k * 1024); } while (0)
#define PG8_MMA(ai, bj, At, Bt) do { __builtin_amdgcn_s_setprio(1); _Pragma("unroll") for (int m = 0; m < 4; ++m) _Pragma("unroll") for (int n = 0; n < 2; ++n) _Pragma("unroll") for (int k = 0; k < 2; ++k) \
    acc[ai][bj][m][n] = __builtin_amdgcn_mfma_f32_16x16x32_bf16(Bt[n][k], At[m][k], acc[ai][bj][m][n], 0, 0, 0); __builtin_amdgcn_s_setprio(0); } while (0)
#define PG8_WAIT_V(n) asm volatile("s_waitcnt vmcnt(" #n ")" ::: "memory")
#define PG8_WAIT_L(n) asm volatile("s_waitcnt lgkmcnt(" #n ")" ::: "memory")
#define PG8_BAR __builtin_amdgcn_s_barrier()
#define PG8_SCHED __builtin_amdgcn_sched_barrier(0)
  Unit cur, nxt; int ui = 0;
  if (!S.next(0, cur)) return;
  f32x4 acc[2][2][4][2];
#pragma unroll
  for (int a = 0; a < 2; ++a)
#pragma unroll
    for (int b = 0; b < 2; ++b)
#pragma unroll
      for (int m = 0; m < 4; ++m)
#pragma unroll
        for (int n = 0; n < 2; ++n) acc[a][b][m][n] = (f32x4){0.f, 0.f, 0.f, 0.f};
  bf16x8 At[4][2], B0[2][2], B1[2][2];
  const char* cA = (const char*)g.A + (size_t)cur.pm * tstepA; const char* cB = (const char*)g.Bt + (size_t)cur.pn * tstepB;
  PG8_STAGE(PG8_SB(0, 0), cB, voffB); PG8_STAGE(PG8_SA(0, 0), cA, voffA); PG8_STAGE(PG8_SB(0, 1), cB + hstepB, voffB); PG8_STAGE(PG8_SA(0, 1), cA + hstepA, voffA);
  if (wr == 1) PG8_BAR;
  PG8_WAIT_V(4); PG8_BAR;
  PG8_STAGE(PG8_SB(1, 0), cB + kstep, voffB); PG8_STAGE(PG8_SA(1, 0), cA + kstep, voffA); PG8_STAGE(PG8_SB(1, 1), cB + hstepB + kstep, voffB);
  PG8_WAIT_V(6); PG8_BAR;
  for (;;) {
    const bool has_next = S.next(ui + 1, nxt);
    const char* nA = has_next ? (const char*)g.A + (size_t)nxt.pm * tstepA : cA; const char* nB = has_next ? (const char*)g.Bt + (size_t)nxt.pn * tstepB : cB;
    for (int t = 0; t < nt; t += 2) {
      const bool last = (t == nt - 2);
      const char* a1 = cA + (size_t)(t + 1) * kstep;
      const char* a2 = last ? nA : cA + (size_t)(t + 2) * kstep; const char* b2 = last ? nB : cB + (size_t)(t + 2) * kstep;
      const char* a3 = a2 + kstep; const char* b3 = b2 + kstep;
      if (HOOK) { if (t == hook_t) E.hook(acc, cur.pm, cur.pn, wr, wc, fr, fq); }
      PG8_LDB(B0, 0, 0); PG8_SCHED; PG8_LDA(At, 0, 0); PG8_STAGE(PG8_SA(1, 1), a1 + hstepA, voffA);
      PG8_WAIT_L(8); PG8_BAR; PG8_WAIT_L(0); PG8_MMA(0, 0, At, B0); PG8_BAR; PG8_SCHED;
      PG8_LDB(B1, 0, 1); PG8_STAGE(PG8_SB(0, 0), b2, voffB);
      PG8_BAR; PG8_WAIT_L(0); PG8_MMA(0, 1, At, B1); PG8_BAR;
      PG8_LDA(At, 0, 1); PG8_STAGE(PG8_SA(0, 0), a2, voffA);
      PG8_BAR; PG8_WAIT_L(0); PG8_MMA(1, 0, At, B0); PG8_BAR; PG8_SCHED;
      PG8_STAGE(PG8_SB(0, 1), b2 + hstepB, voffB);
      PG8_WAIT_V(6); PG8_BAR; PG8_MMA(1, 1, At, B1); PG8_BAR;
      PG8_LDB(B0, 1, 0); PG8_SCHED; PG8_LDA(At, 1, 0); PG8_STAGE(PG8_SA(0, 1), a2 + hstepA, voffA);
      PG8_WAIT_L(8); PG8_BAR; PG8_WAIT_L(0); PG8_MMA(0, 0, At, B0); PG8_BAR; PG8_SCHED;
      PG8_LDB(B1, 1, 1); PG8_STAGE(PG8_SB(1, 0), b3, voffB);
      PG8_BAR; PG8_WAIT_L(0); PG8_MMA(0, 1, At, B1); PG8_BAR;
      PG8_LDA(At, 1, 1); PG8_STAGE(PG8_SA(1, 0), a3, voffA);
      PG8_BAR; PG8_WAIT_L(0); PG8_MMA(1, 0, At, B0); PG8_BAR; PG8_SCHED;
      PG8_STAGE(PG8_SB(1, 1), b3 + hstepB, voffB);
      PG8_WAIT_V(6); PG8_BAR; PG8_MMA(1, 1, At, B1); PG8_BAR;
    }
    E(acc, cur.pm, cur.pn, wr, wc, fr, fq);
    if (!has_next) break;
#pragma unroll
    for (int a = 0; a < 2; ++a)
#pragma unroll
      for (int b = 0; b < 2; ++b)
#pragma unroll
        for (int m = 0; m < 4; ++m)
#pragma unroll
          for (int n = 0; n < 2; ++n) acc[a][b][m][n] = (f32x4){0.f, 0.f, 0.f, 0.f};
    cur = nxt; cA = nA; cB = nB; ++ui;
  }
  PG8_WAIT_V(0);
  if (wr == 0) PG8_BAR;
  PG8_BAR;
#undef PG8_SA
#undef PG8_SB
#undef PG8_STAGE
#undef PG8_LDA
#undef PG8_LDB
#undef PG8_MMA
#undef PG8_WAIT_V
#undef PG8_WAIT_L
#undef PG8_BAR
#undef PG8_SCHED
}
}

typedef f32x4 AccT[2][2][4][2];

struct EpiPlain {
  bf16_t* C; int ldc;
  __device__ __forceinline__ void hook(AccT& acc, int pm, int pn, int wr, int wc, int fr, int fq) const {}
  __device__ __forceinline__ void operator()(const AccT& acc, int pm, int pn, int wr, int wc, int fr, int fq) const {
    const int row0 = pm * 256 + wr * 64 + fr, col0 = pn * 256 + wc * 32 + 8 * fq;
#pragma unroll
    for (int ai = 0; ai < 2; ++ai)
#pragma unroll
      for (int m = 0; m < 4; ++m) { bf16_t* rowp = C + (size_t)(row0 + ai * 128 + m * 16) * ldc + col0;
#pragma unroll
        for (int bj = 0; bj < 2; ++bj) { const f32x4 v0 = acc[ai][bj][m][0], v1 = acc[ai][bj][m][1];
          u32x4 w = {cvtpk(v0[0], v0[1]), cvtpk(v0[2], v0[3]), cvtpk(v1[0], v1[1]), cvtpk(v1[2], v1[3])}; *(u32x4*)(rowp + bj * 128) = w; } }
  }
};

struct EpiWin {
  unsigned char* ws; int l; int Lmask;
  __device__ __forceinline__ void hook(AccT& acc, int pm, int pn, int wr, int wc, int fr, int fq) const {}
  __device__ __forceinline__ void operator()(const AccT& acc, int pm, int pn, int wr, int wc, int fr, int fq) const {
    const int row0 = pm * 256 + wr * 64 + fr;
    if (pn >= 16) {
      bf16_t* G = (bf16_t*)(ws + (((pn - 16) >> 2) ? OFF_GB : OFF_GA));
      const int col0 = ((pn - 16) & 3) * 256 + wc * 32 + 8 * fq;
#pragma unroll
      for (int ai = 0; ai < 2; ++ai)
#pragma unroll
        for (int m = 0; m < 4; ++m) { bf16_t* rowp = G + (size_t)(row0 + ai * 128 + m * 16) * 1024 + col0;
#pragma unroll
          for (int bj = 0; bj < 2; ++bj) { const f32x4 v0 = acc[ai][bj][m][0], v1 = acc[ai][bj][m][1];
            u32x4 w = {cvtpk(sigm(v0[0]), sigm(v0[1])), cvtpk(sigm(v0[2]), sigm(v0[3])), cvtpk(sigm(v1[0]), sigm(v1[1])), cvtpk(sigm(v1[2]), sigm(v1[3]))};
            __builtin_nontemporal_store(w, (u32x4*)(rowp + bj * 128)); } }
      return;
    }
    const int seg = pn >> 1;
    const int cin = (pn & 1) * 256 + wc * 32 + 8 * fq;
    if (seg == 1 || seg == 2) {
      const int dir = seg - 1;
      float* GF = (float*)(ws + OFF_GF);
      const float* LB = (const float*)(ws + OFF_LB) + l * 1024 + dir * 512;
#pragma unroll
      for (int bj = 0; bj < 2; ++bj)
#pragma unroll
        for (int n = 0; n < 2; ++n) { const int c = cin + bj * 128 + n * 4; const f32x4 lb = *(const f32x4*)(LB + c);
#pragma unroll
          for (int ai = 0; ai < 2; ++ai)
#pragma unroll
            for (int m = 0; m < 4; ++m) { const f32x4 v = acc[ai][bj][m][n]; f32x4 o;
#pragma unroll
              for (int j = 0; j < 4; ++j) o[j] = __logf(fmaxf(lb[j], 1e-30f) + (1.f - lb[j]) * sigm(v[j]));
              *(f32x4*)(GF + (size_t)(row0 + ai * 128 + m * 16) * 1024 + dir * 512 + c) = o; } }
      return;
    }
    if (seg == 5 || seg == 6) {
      bf16_t* dst = (bf16_t*)(ws + (seg == 5 ? OFF_QD : OFF_KD));
      const float sc = seg == 5 ? 0.125f : 1.f;
      const float* COS = (const float*)(ws + OFF_COS); const float* SIN = (const float*)(ws + OFF_SIN);
      const int jj = 8 * fq;
#pragma unroll
      for (int ai = 0; ai < 2; ++ai)
#pragma unroll
        for (int m = 0; m < 4; ++m) { const int row = row0 + ai * 128 + m * 16; const int pos = row & Lmask;
          float o1[8], o2[8];
#pragma unroll
          for (int n = 0; n < 2; ++n) { const f32x4 cs = *(const f32x4*)(COS + pos * 32 + jj + 4 * n), sn = *(const f32x4*)(SIN + pos * 32 + jj + 4 * n);
            const f32x4 x1 = acc[ai][0][m][n], x2 = acc[ai][1][m][n];
#pragma unroll
            for (int j = 0; j < 4; ++j) { o1[4 * n + j] = (x1[j] * cs[j] - x2[j] * sn[j]) * sc; o2[4 * n + j] = (x2[j] * cs[j] + x1[j] * sn[j]) * sc; } }
          bf16_t* bp = dst + (size_t)row * 512 + (pn & 1) * 256 + wc * 64 + jj;
          u32x4 w1 = {cvtpk(o1[0], o1[1]), cvtpk(o1[2], o1[3]), cvtpk(o1[4], o1[5]), cvtpk(o1[6], o1[7])};
          u32x4 w2 = {cvtpk(o2[0], o2[1]), cvtpk(o2[2], o2[3]), cvtpk(o2[4], o2[5]), cvtpk(o2[6], o2[7])};
          *(u32x4*)bp = w1; *(u32x4*)(bp + 32) = w2; }
      return;
    }
    bf16_t* dst = (bf16_t*)(ws + (seg == 0 ? OFF_QH : seg == 3 ? OFF_VH : seg == 4 ? OFF_GG : OFF_VD));
    const int mode = seg == 0 ? 1 : (seg == 4 ? 2 : 0);
#pragma unroll
    for (int ai = 0; ai < 2; ++ai)
#pragma unroll
      for (int m = 0; m < 4; ++m) { bf16_t* rowp = dst + (size_t)(row0 + ai * 128 + m * 16) * 512 + cin;
#pragma unroll
        for (int bj = 0; bj < 2; ++bj) { f32x4 v0 = acc[ai][bj][m][0], v1 = acc[ai][bj][m][1];
          if (mode) {
#pragma unroll
            for (int j = 0; j < 4; ++j) { v0[j] = v0[j] * sigm(v0[j]) * (mode == 1 ? 0.08838834764831845f : 1.f); v1[j] = v1[j] * sigm(v1[j]) * (mode == 1 ? 0.08838834764831845f : 1.f); } }
          u32x4 w = {cvtpk(v0[0], v0[1]), cvtpk(v0[2], v0[3]), cvtpk(v1[0], v1[1]), cvtpk(v1[2], v1[3])}; *(u32x4*)(rowp + bj * 128) = w; } }
  }
};

template <int SECOND> struct EpiGate {
  const bf16_t* G; bf16_t* M;
  __device__ __forceinline__ void hook(AccT& acc, int pm, int pn, int wr, int wc, int fr, int fq) const {}
  __device__ __forceinline__ void operator()(const AccT& acc, int pm, int pn, int wr, int wc, int fr, int fq) const {
    const unsigned voff = (unsigned)(fr * 1024 + 8 * fq) * 2u;
    const size_t ub = ((size_t)(pm * 256 + wr * 64) * 1024 + pn * 256 + wc * 32) * 2;
#pragma unroll
    for (int ai = 0; ai < 2; ++ai)
#pragma unroll
      for (int m = 0; m < 4; ++m) { const char* gb = (const char*)G + ub + (size_t)(ai * 128 + m * 16) * 2048; char* mo = (char*)M + ub + (size_t)(ai * 128 + m * 16) * 2048;
#pragma unroll
        for (int bj = 0; bj < 2; ++bj) { const u32x4 b = *(const u32x4*)(gb + voff + bj * 256); const f32x4 v0 = acc[ai][bj][m][0], v1 = acc[ai][bj][m][1];
          float r[8] = {v0[0] * bflo(b[0]), v0[1] * bfhi(b[0]), v0[2] * bflo(b[1]), v0[3] * bfhi(b[1]), v1[0] * bflo(b[2]), v1[1] * bfhi(b[2]), v1[2] * bflo(b[3]), v1[3] * bfhi(b[3])};
          if (SECOND) { const u32x4 pm_ = *(const u32x4*)(mo + voff + bj * 256);
#pragma unroll
            for (int q = 0; q < 4; ++q) { r[2 * q] += bflo(pm_[q]); r[2 * q + 1] += bfhi(pm_[q]); } }
          u32x4 w = {cvtpk(r[0], r[1]), cvtpk(r[2], r[3]), cvtpk(r[4], r[5]), cvtpk(r[6], r[7])};
          *(u32x4*)(mo + voff + bj * 256) = w; } }
  }
};

struct EpiMerge {
  const bf16_t* GA; const bf16_t* GB; bf16_t* M;
  __device__ __forceinline__ void hook(AccT& acc, int pm, int pn, int wr, int wc, int fr, int fq) const {
    const int t_ = otid();
    const unsigned voff = (unsigned)((t_ & 15) * 1024 + 8 * ((t_ >> 4) & 3)) * 2u;
    const size_t ub = ((size_t)(pm * 256 + wr * 64) * 1024 + pn * 256 + wc * 32) * 2;
#pragma unroll
    for (int ai = 0; ai < 2; ++ai)
#pragma unroll
      for (int m = 0; m < 4; ++m) { const char* ga = (const char*)GA + ub + (size_t)(ai * 128 + m * 16) * 2048; const char* gb = (const char*)GB + ub + (size_t)(ai * 128 + m * 16) * 2048;
#pragma unroll
        for (int bj = 0; bj < 2; ++bj) { const u32x4 a = __builtin_nontemporal_load((const u32x4*)(ga + voff + bj * 256)), b = *(const u32x4*)(gb + voff + bj * 256);
          f32x4 v0 = acc[ai][bj][m][0], v1 = acc[ai][bj][m][1];
          v0[0] *= bflo(a[0]) * __builtin_amdgcn_rcpf(fmaxf(bflo(b[0]), 1e-30f)); v0[1] *= bfhi(a[0]) * __builtin_amdgcn_rcpf(fmaxf(bfhi(b[0]), 1e-30f));
          v0[2] *= bflo(a[1]) * __builtin_amdgcn_rcpf(fmaxf(bflo(b[1]), 1e-30f)); v0[3] *= bfhi(a[1]) * __builtin_amdgcn_rcpf(fmaxf(bfhi(b[1]), 1e-30f));
          v1[0] *= bflo(a[2]) * __builtin_amdgcn_rcpf(fmaxf(bflo(b[2]), 1e-30f)); v1[1] *= bfhi(a[2]) * __builtin_amdgcn_rcpf(fmaxf(bfhi(b[2]), 1e-30f));
          v1[2] *= bflo(a[3]) * __builtin_amdgcn_rcpf(fmaxf(bflo(b[3]), 1e-30f)); v1[3] *= bfhi(a[3]) * __builtin_amdgcn_rcpf(fmaxf(bfhi(b[3]), 1e-30f));
          acc[ai][bj][m][0] = v0; acc[ai][bj][m][1] = v1; __builtin_amdgcn_sched_barrier(0); } }
  }
  __device__ __forceinline__ void operator()(const AccT& acc, int pm, int pn, int wr, int wc, int fr, int fq) const {
    const int t_ = otid();
    const unsigned voff = (unsigned)((t_ & 15) * 1024 + 8 * ((t_ >> 4) & 3)) * 2u;
    const size_t ub = ((size_t)(pm * 256 + wr * 64) * 1024 + pn * 256 + wc * 32) * 2;
#pragma unroll
    for (int ai = 0; ai < 2; ++ai)
#pragma unroll
      for (int m = 0; m < 4; ++m) { const char* gb = (const char*)GB + ub + (size_t)(ai * 128 + m * 16) * 2048; char* mo = (char*)M + ub + (size_t)(ai * 128 + m * 16) * 2048;
#pragma unroll
        for (int bj = 0; bj < 2; ++bj) { const u32x4 b = *(const u32x4*)(gb + voff + bj * 256); const f32x4 v0 = acc[ai][bj][m][0], v1 = acc[ai][bj][m][1];
          u32x4 w = {cvtpk(v0[0] * bflo(b[0]), v0[1] * bfhi(b[0])), cvtpk(v0[2] * bflo(b[1]), v0[3] * bfhi(b[1])), cvtpk(v1[0] * bflo(b[2]), v1[1] * bfhi(b[2])), cvtpk(v1[2] * bflo(b[3]), v1[3] * bfhi(b[3]))};
          *(u32x4*)(mo + voff + bj * 256) = w; } }
  }
};

struct EpiPle {
  bf16_t* GE;
  __device__ __forceinline__ void hook(AccT& acc, int pm, int pn, int wr, int wc, int fr, int fq) const {
    const int row0 = pm * 256 + wr * 64 + fr, col0 = pn * 256 + wc * 32 + 8 * fq;
#pragma unroll
    for (int ai = 0; ai < 2; ++ai)
#pragma unroll
      for (int m = 0; m < 4; ++m) { const size_t ro = (size_t)(row0 + ai * 128 + m * 16) * 1024 + col0;
#pragma unroll
        for (int bj = 0; bj < 2; ++bj) { const f32x4 v0 = acc[ai][bj][m][0], v1 = acc[ai][bj][m][1];
          u32x4 w = {cvtpk(v0[0], v0[1]), cvtpk(v0[2], v0[3]), cvtpk(v1[0], v1[1]), cvtpk(v1[2], v1[3])};
          *(u32x4*)(GE + ro + bj * 128) = w; acc[ai][bj][m][0] = (f32x4){0.f, 0.f, 0.f, 0.f}; acc[ai][bj][m][1] = (f32x4){0.f, 0.f, 0.f, 0.f}; } }
  }
  __device__ __forceinline__ void operator()(const AccT& acc, int pm, int pn, int wr, int wc, int fr, int fq) const {
    const int row0 = pm * 256 + wr * 64 + fr, col0 = pn * 256 + wc * 32 + 8 * fq;
#pragma unroll
    for (int ai = 0; ai < 2; ++ai)
#pragma unroll
      for (int m = 0; m < 4; ++m) { const size_t ro = (size_t)(row0 + ai * 128 + m * 16) * 1024 + col0;
#pragma unroll
        for (int bj = 0; bj < 2; ++bj) { const u32x4 e = *(const u32x4*)(GE + ro + bj * 128); const f32x4 v0 = acc[ai][bj][m][0], v1 = acc[ai][bj][m][1];
          u32x4 w = {cvtpk(sigm(v0[0]) * bflo(e[0]), sigm(v0[1]) * bfhi(e[0])), cvtpk(sigm(v0[2]) * bflo(e[1]), sigm(v0[3]) * bfhi(e[1])),
                     cvtpk(sigm(v1[0]) * bflo(e[2]), sigm(v1[1]) * bfhi(e[2])), cvtpk(sigm(v1[2]) * bflo(e[3]), sigm(v1[3]) * bfhi(e[3]))};
          *(u32x4*)(GE + ro + bj * 128) = w; } }
  }
};

__device__ __forceinline__ void transpose_tile(const float* __restrict__ src, int N, bf16_t* __restrict__ dst, int ldb, int koff, int kt, int ntile, int perm_mode, float* ldsf) {
  const int tid = otid();
  const int k0 = kt * 64, n0 = ntile * 64;
  { const int r = tid >> 4, c4 = (tid & 15) * 4;
#pragma unroll
    for (int h = 0; h < 2; ++h) { const int rr = r + h * 32; const f32x4 v = __builtin_nontemporal_load((const f32x4*)(src + (size_t)(k0 + rr) * N + n0 + c4));
      ldsf[rr * 65 + c4 + 0] = v[0]; ldsf[rr * 65 + c4 + 1] = v[1]; ldsf[rr * 65 + c4 + 2] = v[2]; ldsf[rr * 65 + c4 + 3] = v[3]; } }
  __syncthreads();
  { const int n = tid >> 3, k8 = (tid & 7) * 8;
    float v[8];
#pragma unroll
    for (int i = 0; i < 8; ++i) v[i] = ldsf[(k8 + i) * 65 + n];
    int c = n0 + n;
    const bool rope_cols = (perm_mode == 3) && c >= 2560 && c < 3584;
    if (rope_cols) { const int cl = c & 255, b = cl >> 6, half = (cl >> 5) & 1, jj = cl & 31;
      c = (c & ~255) + 128 * half + 32 * b + 16 * ((jj >> 2) & 1) + 4 * ((jj >> 3) & 3) + (jj & 3); }
    if (perm_mode == 2 || (perm_mode == 3 && !rope_cols)) c = (c & ~31) + 16 * ((c >> 2) & 1) + 4 * ((c >> 3) & 3) + (c & 3);
    u32x4 w = {cvtpk(v[0], v[1]), cvtpk(v[2], v[3]), cvtpk(v[4], v[5]), cvtpk(v[6], v[7])};
    *(u32x4*)(dst + (size_t)c * ldb + koff + k0 + k8) = w; }
  __syncthreads();
}

__device__ void prep_phase(const Params& p, unsigned char* smem) {
  float* ldsf = (float*)smem;
  const int TPL = 4480;
  for (int tl = blockIdx.x; tl < TPL * NL; tl += gridDim.x) {
    const int l = tl / TPL; int r = tl % TPL;
    unsigned char* wl = p.ws + (size_t)l * SZ_WL;
    if (r < 1536) { transpose_tile(p.w_in + (size_t)l * 1024 * INC, INC, (bf16_t*)(wl + OFF_WIN), 1024, 0, r / 96, r % 96, 3, ldsf); continue; } r -= 1536;
    if (r < 128) { transpose_tile(p.w_a + (size_t)l * 512 * 1024, 1024, (bf16_t*)(wl + OFF_WAB), 1024, 0, r / 16, r % 16, 2, ldsf); continue; } r -= 128;
    if (r < 128) { transpose_tile(p.w_b + (size_t)l * 512 * 1024, 1024, (bf16_t*)(wl + OFF_WAB), 1024, 512, r / 16, r % 16, 2, ldsf); continue; } r -= 128;
    if (r < 256) { transpose_tile(p.w_out + (size_t)l * 1024 * 1024, 1024, (bf16_t*)(wl + OFF_WOUT), 1024, 0, r / 16, r % 16, 2, ldsf); continue; } r -= 256;
    if (r < 1408) { transpose_tile(p.w_up + (size_t)l * 1024 * FF2, FF2, (bf16_t*)(wl + OFF_WUP), 1024, 0, r / 88, r % 88, 2, ldsf); continue; } r -= 1408;
    if (r < 704) { transpose_tile(p.w_down + (size_t)l * FF * 1024, 1024, (bf16_t*)(wl + OFF_WDOWN), FF, 0, r / 16, r % 16, 2, ldsf); continue; } r -= 704;
    if (r < 64) { transpose_tile(p.w_ple + (size_t)l * 256 * 1024, 1024, (bf16_t*)(wl + OFF_WPG), 1280, 0, r / 16, r % 16, 2, ldsf); continue; } r -= 64;
    transpose_tile(p.w_pg + (size_t)l * 1024 * 1024, 1024, (bf16_t*)(wl + OFF_WPG), 1280, 256, r / 16, r % 16, 2, ldsf);
  }
  const int gt = obid() * 512 + otid(), gn = gridDim.x * 512;
  float* LB = (float*)(p.ws + OFF_LB); float* LAM = (float*)(p.ws + OFF_LAM);
  float* COS = (float*)(p.ws + OFF_COS); float* SIN = (float*)(p.ws + OFF_SIN);
  for (int i = gt; i < 1024; i += gn) {
    const float x0 = p.lb_logits[i], x1 = p.lb_logits[1024 + i], x2 = p.lb_logits[2048 + i], x3 = p.lb_logits[3072 + i];
    const float mx = fmaxf(fmaxf(x0, x1), fmaxf(x2, x3));
    const float e0 = expf(x0 - mx), e1 = expf(x1 - mx), e2 = expf(x2 - mx), e3 = expf(x3 - mx), s = e0 + e1 + e2 + e3;
    LB[i] = 0.f; LB[1024 + i] = e1 / s; LB[2048 + i] = (e1 + e2) / s; LB[3072 + i] = (e1 + e2 + e3) / s;
  }
  if (gt < NL) {
    const float* lp = p.dlam + gt * 256; float d1 = 0.f, d2 = 0.f;
    for (int i = 0; i < 64; ++i) { d1 += lp[i] * lp[64 + i]; d2 += lp[128 + i] * lp[192 + i]; }
    const float li = 0.8f - 0.6f * expf(-0.3f * (float)gt);
    LAM[gt] = expf(d1) - expf(d2) + li; LAM[8 + gt] = 1.f - li;
  }
  for (int i = gt; i < 4096 * 32; i += gn) {
    const int pos = i >> 5, j = i & 31;
    const float inv = 1.0f / exp2f((float)j * (13.287712379549449f / 32.f));
    const float ang = (float)pos * inv;
    double rev = (double)ang * 0.15915494309189535; rev -= rint(rev);
    COS[i] = __builtin_amdgcn_cosf((float)rev); SIN[i] = __builtin_amdgcn_sinf((float)rev);
  }
}

__device__ void rowwise_phase(const float* __restrict__ xin, float* __restrict__ xres, const bf16_t* __restrict__ y, const float* __restrict__ w_post,
                              const float* __restrict__ w_next, bool do_next, bf16_t* __restrict__ Hout, int ldh, int hoff, const float* __restrict__ p_src, int T, bool final_f32) {
  const int tid_ = otid(); const int wid = tid_ >> 6, lane = tid_ & 63;
  for (int row = obid() * 8 + wid; row < T; row += gridDim.x * 8) {
    float x[16];
    if (y) {
#pragma unroll
      for (int c = 0; c < 2; ++c) { const u32x4 w = __builtin_nontemporal_load((const u32x4*)((const bf16_t*)(xres + (size_t)row * 1024) + c * 512 + lane * 8));
#pragma unroll
        for (int i = 0; i < 4; ++i) { x[c * 8 + 2 * i] = bflo(w[i]); x[c * 8 + 2 * i + 1] = bfhi(w[i]); } }
    } else {
#pragma unroll
      for (int c = 0; c < 2; ++c) { const float* xp = xin + (size_t)row * 1024 + c * 512 + lane * 8;
        const f32x4 a = __builtin_nontemporal_load((const f32x4*)xp), b = __builtin_nontemporal_load((const f32x4*)(xp + 4));
        x[c * 8 + 0] = a[0]; x[c * 8 + 1] = a[1]; x[c * 8 + 2] = a[2]; x[c * 8 + 3] = a[3]; x[c * 8 + 4] = b[0]; x[c * 8 + 5] = b[1]; x[c * 8 + 6] = b[2]; x[c * 8 + 7] = b[3]; }
    }
    if (y) {
      float yv[16]; float ss = 0.f;
#pragma unroll
      for (int c = 0; c < 2; ++c) { const u32x4 w = __builtin_nontemporal_load((const u32x4*)(y + (size_t)row * 1024 + c * 512 + lane * 8));
#pragma unroll
        for (int i = 0; i < 4; ++i) { yv[c * 8 + 2 * i] = bflo(w[i]); yv[c * 8 + 2 * i + 1] = bfhi(w[i]); } }
#pragma unroll
      for (int i = 0; i < 16; ++i) ss += yv[i] * yv[i];
      ss = wave_sum(ss);
      const float rs = rsqrtf(ss * (1.f / 1024.f) + EPS);
#pragma unroll
      for (int c = 0; c < 2; ++c) { const float* wp = w_post + c * 512 + lane * 8; const f32x4 a = *(const f32x4*)wp, b = *(const f32x4*)(wp + 4);
        x[c * 8 + 0] += yv[c * 8 + 0] * rs * a[0]; x[c * 8 + 1] += yv[c * 8 + 1] * rs * a[1]; x[c * 8 + 2] += yv[c * 8 + 2] * rs * a[2]; x[c * 8 + 3] += yv[c * 8 + 3] * rs * a[3];
        x[c * 8 + 4] += yv[c * 8 + 4] * rs * b[0]; x[c * 8 + 5] += yv[c * 8 + 5] * rs * b[1]; x[c * 8 + 6] += yv[c * 8 + 6] * rs * b[2]; x[c * 8 + 7] += yv[c * 8 + 7] * rs * b[3]; }
    }
    if (final_f32) {
#pragma unroll
      for (int c = 0; c < 2; ++c) { float* xp = xres + (size_t)row * 1024 + c * 512 + lane * 8;
        __builtin_nontemporal_store((f32x4){x[c * 8 + 0], x[c * 8 + 1], x[c * 8 + 2], x[c * 8 + 3]}, (f32x4*)xp); __builtin_nontemporal_store((f32x4){x[c * 8 + 4], x[c * 8 + 5], x[c * 8 + 6], x[c * 8 + 7]}, (f32x4*)(xp + 4)); }
    } else {
#pragma unroll
      for (int c = 0; c < 2; ++c) { u32x4 w;
#pragma unroll
        for (int i = 0; i < 4; ++i) w[i] = cvtpk(x[c * 8 + 2 * i], x[c * 8 + 2 * i + 1]);
        __builtin_nontemporal_store(w, (u32x4*)((bf16_t*)(xres + (size_t)row * 1024) + c * 512 + lane * 8)); }
    }
    if (do_next) {
      float s2 = 0.f;
#pragma unroll
      for (int i = 0; i < 16; ++i) s2 += x[i] * x[i];
      s2 = wave_sum(s2);
      const float r2 = rsqrtf(s2 * (1.f / 1024.f) + EPS);
#pragma unroll
      for (int c = 0; c < 2; ++c) { float wv[8];
        if (w_next) { const float* wp = w_next + c * 512 + lane * 8; const f32x4 a = *(const f32x4*)wp, b = *(const f32x4*)(wp + 4);
          wv[0] = a[0]; wv[1] = a[1]; wv[2] = a[2]; wv[3] = a[3]; wv[4] = b[0]; wv[5] = b[1]; wv[6] = b[2]; wv[7] = b[3]; }
        else {
#pragma unroll
          for (int i = 0; i < 8; ++i) wv[i] = 1.f; }
        u32x4 w;
#pragma unroll
        for (int i = 0; i < 4; ++i) w[i] = cvtpk(x[c * 8 + 2 * i] * r2 * wv[2 * i], x[c * 8 + 2 * i + 1] * r2 * wv[2 * i + 1]);
        *(u32x4*)(Hout + (size_t)row * ldh + hoff + c * 512 + lane * 8) = w; }
      if (p_src) { const f32x4 pv = __builtin_nontemporal_load((const f32x4*)(p_src + (size_t)row * 256 + lane * 4));
        u32x2 w = {cvtpk(pv[0], pv[1]), cvtpk(pv[2], pv[3])}; *(u32x2*)(Hout + (size_t)row * ldh + lane * 4) = w; }
    }
  }
}

__device__ void conv_phase(const bf16_t* __restrict__ U, const float* __restrict__ cw, const float* __restrict__ cb, bf16_t* __restrict__ ACT, int Lmask, int T) {
  const int gt = obid() * 512 + otid(), gn = gridDim.x * 512;
  for (int u = gt; u < (T / 16) * 352; u += gn) {
    const int j8 = u % 352, rb = u / 352, r0 = rb * 16, c0 = j8 * 8;
    float w0g[8], w1g[8], w2g[8], bg[8], w0v[8], w1v[8], w2v[8], bv[8];
#pragma unroll
    for (int i = 0; i < 8; ++i) { w0g[i] = cw[c0 + i]; w1g[i] = cw[FF2 + c0 + i]; w2g[i] = cw[2 * FF2 + c0 + i]; bg[i] = cb[c0 + i];
      w0v[i] = cw[FF + c0 + i]; w1v[i] = cw[FF2 + FF + c0 + i]; w2v[i] = cw[2 * FF2 + FF + c0 + i]; bv[i] = cb[FF + c0 + i]; }
    const u32x4 z4 = {0u, 0u, 0u, 0u};
    u32x4 pg = z4, pv = z4, cg_ = z4, cv = z4, ng, nv;
    if ((r0 & Lmask) != 0) { pg = __builtin_nontemporal_load((const u32x4*)(U + (size_t)(r0 - 1) * FF2 + c0)); pv = __builtin_nontemporal_load((const u32x4*)(U + (size_t)(r0 - 1) * FF2 + FF + c0)); }
    cg_ = __builtin_nontemporal_load((const u32x4*)(U + (size_t)r0 * FF2 + c0)); cv = __builtin_nontemporal_load((const u32x4*)(U + (size_t)r0 * FF2 + FF + c0));
    for (int i = 0; i < 16; ++i) {
      const int row = r0 + i;
      if (((row + 1) & Lmask) != 0) { ng = __builtin_nontemporal_load((const u32x4*)(U + (size_t)(row + 1) * FF2 + c0)); nv = __builtin_nontemporal_load((const u32x4*)(U + (size_t)(row + 1) * FF2 + FF + c0)); }
      else { ng = z4; nv = z4; }
      float o[8];
#pragma unroll
      for (int q = 0; q < 4; ++q) {
#pragma unroll
        for (int hh = 0; hh < 2; ++hh) { const int e = q * 2 + hh;
          const float gp = hh ? bfhi(pg[q]) : bflo(pg[q]), gc = hh ? bfhi(cg_[q]) : bflo(cg_[q]), gnx = hh ? bfhi(ng[q]) : bflo(ng[q]);
          const float vp = hh ? bfhi(pv[q]) : bflo(pv[q]), vc = hh ? bfhi(cv[q]) : bflo(cv[q]), vnx = hh ? bfhi(nv[q]) : bflo(nv[q]);
          const float g = gp * w0g[e] + gc * w1g[e] + gnx * w2g[e] + bg[e];
          const float v = vp * w0v[e] + vc * w1v[e] + vnx * w2v[e] + bv[e];
          const float ge = g * sigm(1.5957691216057308f * (g + 0.044715f * g * g * g));
          o[e] = ge * v; } }
      u32x4 w = {cvtpk(o[0], o[1]), cvtpk(o[2], o[3]), cvtpk(o[4], o[5]), cvtpk(o[6], o[7])};
      *(u32x4*)(ACT + (size_t)row * FF + c0) = w;
      pg = cg_; pv = cv; cg_ = ng; cv = nv;
    }
  }
}

__device__ void hg_delta_phase(const Params& p, unsigned char* smem, int T) {
  const int tid = otid(), wid = tid >> 6, lane = tid & 63, fr = lane & 15, fq = lane >> 4;
  bf16_t* KT = (bf16_t*)smem;
  bf16_t* VT = KT + 128 * 72;
  float* tot = (float*)(VT + 128 * 72);
  const float* GF = (const float*)(p.ws + OFF_GF); const bf16_t* VH = (const bf16_t*)(p.ws + OFF_VH);
  bf16_t* ST = (bf16_t*)(p.ws + OFF_ST); float* DC = (float*)(p.ws + OFF_DC);
  const int ch = tid & 127, part = tid >> 7;
  for (int item = blockIdx.x; item < (T / 64) * 8; item += gridDim.x) {
    const int d = item & 1, h = (item >> 1) & 3, cgl = item >> 3, t0 = cgl * 64;
    float g[16], pl[16]; float run = 0.f;
#pragma unroll
    for (int i = 0; i < 16; ++i) g[i] = GF[(size_t)(t0 + part * 16 + i) * 1024 + d * 512 + h * 128 + ch];
    unsigned short vv[16];
#pragma unroll
    for (int i = 0; i < 16; ++i) vv[i] = VH[(size_t)(t0 + part * 16 + i) * 512 + h * 128 + ch];
#pragma unroll
    for (int i = 0; i < 16; ++i) { pl[i] = run; run += g[i]; }
    const float lt = run;
    tot[part * 128 + ch] = lt;
    { u32x4 w0, w1;
#pragma unroll
      for (int i = 0; i < 4; ++i) { w0[i] = (unsigned)vv[2 * i] | ((unsigned)vv[2 * i + 1] << 16); w1[i] = (unsigned)vv[8 + 2 * i] | ((unsigned)vv[8 + 2 * i + 1] << 16); }
      *(u32x4*)(VT + ch * 72 + part * 16) = w0; *(u32x4*)(VT + ch * 72 + part * 16 + 8) = w1; }
    __syncthreads();
    const float t0s = tot[ch], t1s = tot[128 + ch], t2s = tot[256 + ch], t3s = tot[384 + ch];
    const float before = (part > 0 ? t0s : 0.f) + (part > 1 ? t1s : 0.f) + (part > 2 ? t2s : 0.f);
    const float after = (part < 1 ? t1s : 0.f) + (part < 2 ? t2s : 0.f) + (part < 3 ? t3s : 0.f);
    if (part == 0) DC[(size_t)item * 128 + ch] = fexp(t0s + t1s + t2s + t3s);
    { float kt[16];
#pragma unroll
      for (int i = 0; i < 16; ++i) { const float E = d == 0 ? after + (lt - pl[i] - g[i]) : before + pl[i]; kt[i] = (1.f - fexp(g[i])) * fexp(E); }
      u32x4 w0, w1;
#pragma unroll
      for (int i = 0; i < 4; ++i) { w0[i] = cvtpk(kt[2 * i], kt[2 * i + 1]); w1[i] = cvtpk(kt[8 + 2 * i], kt[8 + 2 * i + 1]); }
      *(u32x4*)(KT + ch * 72 + part * 16) = w0; *(u32x4*)(KT + ch * 72 + part * 16 + 8) = w1; }
    __syncthreads();
    bf16x8 af[2];
#pragma unroll
    for (int ks = 0; ks < 2; ++ks) af[ks] = *(const bf16x8*)(KT + (wid * 16 + fr) * 72 + ks * 32 + fq * 8);
    bf16_t* Sout = ST + (size_t)item * 16384;
#pragma unroll
    for (int vb = 0; vb < 8; ++vb) { f32x4 c = {0.f, 0.f, 0.f, 0.f};
#pragma unroll
      for (int ks = 0; ks < 2; ++ks) { const bf16x8 bfg = *(const bf16x8*)(VT + (vb * 16 + fr) * 72 + ks * 32 + fq * 8); c = mfma16(af[ks], bfg, c); }
      u32x2 w = {cvtpk(c[0], c[1]), cvtpk(c[2], c[3])};
      *(u32x2*)(Sout + ((wid * 8 + vb) * 64 + lane) * 4) = w; }
    __syncthreads();
  }
}

__device__ void hg_scan_phase(const Params& p, int nseq, int nc) {
  bf16_t* ST = (bf16_t*)(p.ws + OFF_ST); const float* DC = (const float*)(p.ws + OFF_DC);
  const int gt = obid() * 512 + otid(), gn = gridDim.x * 512;
  const int nchain = nseq * 8;
  for (int vi = gt; vi < nchain * 2048; vi += gn) {
    const int chain = vi >> 11, e8 = (vi & 2047) * 8, k0 = 16 * (e8 >> 11) + 4 * ((e8 >> 6) & 3);
    const int d = chain & 1, h = (chain >> 1) & 3, s = chain >> 3;
    float run[8];
#pragma unroll
    for (int i = 0; i < 8; ++i) run[i] = 0.f;
    for (int cc = 0; cc < nc; cc += 8) {
      u32x4 dl[8]; f32x4 da[8];
#pragma unroll
      for (int q = 0; q < 8; ++q) { const int c = d == 0 ? (cc + q) : (nc - 1 - cc - q); const size_t it = (size_t)((s * nc + c) * 4 + h) * 2 + d;
        dl[q] = *(const u32x4*)(ST + it * 16384 + e8); da[q] = *(const f32x4*)(DC + it * 128 + k0); }
#pragma unroll
      for (int q = 0; q < 8; ++q) { const int c = d == 0 ? (cc + q) : (nc - 1 - cc - q); const size_t it = (size_t)((s * nc + c) * 4 + h) * 2 + d;
        u32x4 w = {cvtpk(run[0], run[1]), cvtpk(run[2], run[3]), cvtpk(run[4], run[5]), cvtpk(run[6], run[7])};
        *(u32x4*)(ST + it * 16384 + e8) = w;
        run[0] = da[q][0] * run[0] + bflo(dl[q][0]); run[1] = da[q][1] * run[1] + bfhi(dl[q][0]);
        run[2] = da[q][2] * run[2] + bflo(dl[q][1]); run[3] = da[q][3] * run[3] + bfhi(dl[q][1]);
        run[4] = da[q][0] * run[4] + bflo(dl[q][2]); run[5] = da[q][1] * run[5] + bfhi(dl[q][2]);
        run[6] = da[q][2] * run[6] + bflo(dl[q][3]); run[7] = da[q][3] * run[7] + bfhi(dl[q][3]); }
    }
  }
}

__device__ void hg_out_phase(const Params& p, int l, unsigned char* smem, int T) {
  const int tid = otid(), wid = tid >> 6, lane = tid & 63, fr = lane & 15, fq = lane >> 4;
  bf16_t* QT = (bf16_t*)smem;
  bf16_t* KT2 = QT + 64 * 136;
  bf16_t* QHt = KT2 + 64 * 136;
  bf16_t* VT = QHt + 64 * 136;
  bf16_t* Pm = VT + 128 * 72;
  float* tot = (float*)(Pm + 64 * 72);
  float* Of = tot + 512;
  const float* GF = (const float*)(p.ws + OFF_GF); const bf16_t* VH = (const bf16_t*)(p.ws + OFF_VH);
  const bf16_t* QH = (const bf16_t*)(p.ws + OFF_QH); const bf16_t* GG = (const bf16_t*)(p.ws + OFF_GG);
  const bf16_t* ST = (const bf16_t*)(p.ws + OFF_ST); bf16_t* AB = (bf16_t*)(p.ws + OFF_AB);
  const int ch = tid & 127, part = tid >> 7;
  for (int item = blockIdx.x; item < (T / 64) * 4; item += gridDim.x) {
    const int h = item & 3, cgl = item >> 2, t0 = cgl * 64;
    f32x4 acc[4];
#pragma unroll
    for (int i = 0; i < 4; ++i) acc[i] = (f32x4){0.f, 0.f, 0.f, 0.f};
    { unsigned short vv[16];
#pragma unroll
      for (int i = 0; i < 16; ++i) vv[i] = VH[(size_t)(t0 + part * 16 + i) * 512 + h * 128 + ch];
      u32x4 w0, w1;
#pragma unroll
      for (int i = 0; i < 4; ++i) { w0[i] = (unsigned)vv[2 * i] | ((unsigned)vv[2 * i + 1] << 16); w1[i] = (unsigned)vv[8 + 2 * i] | ((unsigned)vv[8 + 2 * i + 1] << 16); }
      *(u32x4*)(VT + ch * 72 + part * 16) = w0; *(u32x4*)(VT + ch * 72 + part * 16 + 8) = w1; }
#pragma unroll 1
    for (int d = 0; d < 2; ++d) {
      float g[16], pl[16]; unsigned short qq[16]; float run = 0.f;
#pragma unroll
      for (int i = 0; i < 16; ++i) g[i] = GF[(size_t)(t0 + part * 16 + i) * 1024 + d * 512 + h * 128 + ch];
#pragma unroll
      for (int i = 0; i < 16; ++i) qq[i] = QH[(size_t)(t0 + part * 16 + i) * 512 + h * 128 + ch];
#pragma unroll
      for (int i = 0; i < 16; ++i) { pl[i] = run; run += g[i]; }
      const float lt = run;
      tot[part * 128 + ch] = lt;
      __syncthreads();
      const float t0s = tot[ch], t1s = tot[128 + ch], t2s = tot[256 + ch], t3s = tot[384 + ch];
      const float before = (part > 0 ? t0s : 0.f) + (part > 1 ? t1s : 0.f) + (part > 2 ? t2s : 0.f);
      const float after = (part < 1 ? t1s : 0.f) + (part < 2 ? t2s : 0.f) + (part < 3 ? t3s : 0.f);
      const float cref = d == 0 ? (t0s + t1s) : (t2s + t3s);
#pragma unroll
      for (int i = 0; i < 16; ++i) { const int tok = part * 16 + i;
        const float b = d == 0 ? before + pl[i] + g[i] : after + (lt - pl[i]);
        const float q = bf2f(qq[i]); const float k = 1.f - fexp(g[i]);
        QT[tok * 136 + ch] = f2bf(q * fexp(b - cref)); KT2[tok * 136 + ch] = f2bf(k * fexp(cref - b)); QHt[tok * 136 + ch] = f2bf(q * fexp(b)); }
      __syncthreads();
      { const int rb = wid >> 1;
#pragma unroll
        for (int cbi = 0; cbi < 2; ++cbi) { const int cb = (wid & 1) * 2 + cbi; f32x4 a = {0.f, 0.f, 0.f, 0.f};
#pragma unroll
          for (int ks = 0; ks < 4; ++ks) { const bf16x8 A = *(const bf16x8*)(QT + (rb * 16 + fr) * 136 + ks * 32 + fq * 8), B = *(const bf16x8*)(KT2 + (cb * 16 + fr) * 136 + ks * 32 + fq * 8); a = mfma16(A, B, a); }
#pragma unroll
          for (int j = 0; j < 4; ++j) { const int t = rb * 16 + fq * 4 + j, s = cb * 16 + fr; const bool keep = d == 0 ? (s <= t) : (s >= t);
            Pm[t * 72 + s] = f2bf(keep ? a[j] : 0.f); } } }
      __syncthreads();
      { const bf16_t* S = ST + ((size_t)(cgl * 4 + h) * 2 + d) * 16384;
        bf16x8 Bs[4];
#pragma unroll
        for (int ks = 0; ks < 4; ++ks) { const int q = 4 * ks + fq;
          const bf16_t* e1 = S + (((q >> 1) * 8 + wid) * 64 + (2 * (q & 1)) * 16 + fr) * 4;
          const u32x2 lo = *(const u32x2*)e1, hi = *(const u32x2*)(e1 + 64);
          u32x4 w4 = {lo[0], lo[1], hi[0], hi[1]}; Bs[ks] = *reinterpret_cast<bf16x8*>(&w4); }
        bf16x8 Bv[2];
#pragma unroll
        for (int ks = 0; ks < 2; ++ks) Bv[ks] = *(const bf16x8*)(VT + (wid * 16 + fr) * 72 + ks * 32 + fq * 8);
#pragma unroll
        for (int rbb = 0; rbb < 4; ++rbb) {
#pragma unroll
          for (int ks = 0; ks < 2; ++ks) { const bf16x8 A = *(const bf16x8*)(Pm + (rbb * 16 + fr) * 72 + ks * 32 + fq * 8); acc[rbb] = mfma16(A, Bv[ks], acc[rbb]); }
#pragma unroll
          for (int ks = 0; ks < 4; ++ks) { const bf16x8 A = *(const bf16x8*)(QHt + (rbb * 16 + fr) * 136 + ks * 32 + fq * 8); acc[rbb] = mfma16(A, Bs[ks], acc[rbb]); } } }
      __syncthreads();
    }
#pragma unroll
    for (int rbb = 0; rbb < 4; ++rbb)
#pragma unroll
      for (int j = 0; j < 4; ++j) Of[(rbb * 16 + fq * 4 + j) * 132 + wid * 16 + fr] = acc[rbb][j];
    __syncthreads();
    { const int tok = tid >> 3, c0 = (tid & 7) * 16; float v[16]; float ss = 0.f;
#pragma unroll
      for (int i = 0; i < 16; ++i) { v[i] = Of[tok * 132 + c0 + i]; ss += v[i] * v[i]; }
      ss += __shfl_xor(ss, 1, 64); ss += __shfl_xor(ss, 2, 64); ss += __shfl_xor(ss, 4, 64);
      const float rs = rsqrtf(ss * (1.f / 128.f) + EPS);
      const u32x4 g0 = *(const u32x4*)(GG + (size_t)(t0 + tok) * 512 + h * 128 + c0), g1 = *(const u32x4*)(GG + (size_t)(t0 + tok) * 512 + h * 128 + c0 + 8);
      const float* gw = p.gnorm + l * 128 + c0;
      float o[16];
#pragma unroll
      for (int i = 0; i < 4; ++i) { o[2 * i] = v[2 * i] * rs * gw[2 * i] * bflo(g0[i]); o[2 * i + 1] = v[2 * i + 1] * rs * gw[2 * i + 1] * bfhi(g0[i]);
        o[8 + 2 * i] = v[8 + 2 * i] * rs * gw[8 + 2 * i] * bflo(g1[i]); o[8 + 2 * i + 1] = v[8 + 2 * i + 1] * rs * gw[8 + 2 * i + 1] * bfhi(g1[i]); }
      u32x4 w0, w1;
#pragma unroll
      for (int i = 0; i < 4; ++i) { w0[i] = cvtpk(o[2 * i], o[2 * i + 1]); w1[i] = cvtpk(o[8 + 2 * i], o[8 + 2 * i + 1]); }
      bf16_t* op = AB + (size_t)(t0 + tok) * 1024 + h * 128 + c0;
      *(u32x4*)op = w0; *(u32x4*)(op + 8) = w1; }
    __syncthreads();
  }
}

constexpr int SHM_V = 64 * 128 * 2, SHM_K = 64 * 128 * 2;
#define KSWZ(row, colB) ((row) * 256 + ((colB) ^ (((row) & 7) << 4)))
#define SBAR() __builtin_amdgcn_sched_barrier(0)
__device__ __forceinline__ int crow(int r, int hi) { return (r & 3) + 8 * (r >> 2) + 4 * hi; }
__device__ __forceinline__ void partialSM(f32x16& p0, f32x16& p1, float& m_reg, float& mn, float& alpha) {
  constexpr float C = 1.4426950408889634f; constexpr float THR = 8.f;
  float pmax = p0[0];
#pragma unroll
  for (int r = 1; r < 16; ++r) pmax = fmaxf(pmax, p0[r]);
#pragma unroll
  for (int r = 0; r < 16; ++r) pmax = fmaxf(pmax, p1[r]);
  { auto rr = __builtin_amdgcn_permlane32_swap(__float_as_uint(pmax), __float_as_uint(pmax), false, false);
    pmax = fmaxf(__uint_as_float(rr[0]), __uint_as_float(rr[1])); }
  if (__builtin_expect(__all(pmax - m_reg <= THR), 1)) { mn = m_reg; alpha = 1.f; }
  else { mn = fmaxf(m_reg, pmax); alpha = __builtin_amdgcn_exp2f((m_reg - mn) * C); m_reg = mn; }
  const float mnC = -mn * C;
#pragma unroll
  for (int r = 0; r < 16; ++r) p0[r] = __builtin_amdgcn_exp2f(fmaf(p0[r], C, mnC));
#pragma unroll
  for (int r = 0; r < 16; ++r) p1[r] = __builtin_amdgcn_exp2f(fmaf(p1[r], C, mnC));
}
__device__ __forceinline__ void finishSM(f32x16& p0, f32x16& p1, float alpha, float& l_reg, bf16x8& pa0, bf16x8& pa1, bf16x8& pa2, bf16x8& pa3) {
  float ps = 0;
#pragma unroll
  for (int r = 0; r < 16; ++r) ps += p0[r];
#pragma unroll
  for (int r = 0; r < 16; ++r) ps += p1[r];
  { auto rr = __builtin_amdgcn_permlane32_swap(__float_as_uint(ps), __float_as_uint(ps), false, false);
    ps = __uint_as_float(rr[0]) + __uint_as_float(rr[1]); }
  l_reg = l_reg * alpha + ps;
#define PK4(P, BASE, OUT) do { unsigned a0 = cvtpk(P[BASE + 0], P[BASE + 1]), a1 = cvtpk(P[BASE + 2], P[BASE + 3]);   \
    unsigned b0 = cvtpk(P[BASE + 4], P[BASE + 5]), b1 = cvtpk(P[BASE + 6], P[BASE + 7]);                              \
    auto r0 = __builtin_amdgcn_permlane32_swap(a0, b0, false, false); auto r1 = __builtin_amdgcn_permlane32_swap(a1, b1, false, false); \
    u32x4 w = {r0[0], r1[0], r0[1], r1[1]}; OUT = *reinterpret_cast<bf16x8*>(&w); } while (0)
  PK4(p0, 0, pa0); PK4(p0, 8, pa1); PK4(p1, 0, pa2); PK4(p1, 8, pa3);
#undef PK4
}
template <int H>
__device__ __forceinline__ void qkt_half(f32x16& p0, f32x16& p1, const char* Ks, const bf16x8* qr, int r32, int hi) {
#pragma unroll
  for (int r = 0; r < 16; ++r) { p0[r] = 0.f; p1[r] = 0.f; }
#pragma unroll
  for (int d0 = 0; d0 < 4; ++d0) { const int cb = ((H * 4 + d0) * 16 + hi * 8) * 2;
    const bf16x8 b0 = *reinterpret_cast<const bf16x8*>(Ks + KSWZ(r32, cb));
    const bf16x8 b1 = *reinterpret_cast<const bf16x8*>(Ks + KSWZ(32 + r32, cb));
    p0 = __builtin_amdgcn_mfma_f32_32x32x16_bf16(b0, qr[H * 4 + d0], p0, 0, 0, 0);
    p1 = __builtin_amdgcn_mfma_f32_32x32x16_bf16(b1, qr[H * 4 + d0], p1, 0, 0, 0); }
}
__device__ __forceinline__ int v_st(int k, int c) { const int kk = (k & ~0xC) | ((k & 4) << 1) | ((k & 8) >> 1); return ((kk >> 3) * 4 + (c >> 5)) * 512 + ((kk & 7) * 32 + (c & 31)) * 2; }
__device__ __forceinline__ int v_rd_base(int lane) { return ((lane & 3) << 3) | (((lane >> 2) & 3) << 6) | (((lane >> 4) & 1) << 5) | (((lane >> 5) & 1) << 8); }
constexpr int v_rd_off(int d0, int ks, int half) { return d0 * 512 + ks * 4096 + half * 2048; }
template <int OFF> __device__ __forceinline__ s16x4 tr_read(int vb) {
  s16x4 r; asm volatile("ds_read_b64_tr_b16 %0, %1 offset:%2" : "=&v"(r) : "v"(vb), "i"(OFF) : "memory"); return r;
}
struct VB8 { s16x4 l0, h0, l1, h1, l2, h2, l3, h3; };
template <int D0> __device__ __forceinline__ void pv_rd(VB8& r, int vb) {
  r.l0 = tr_read<v_rd_off(D0, 0, 0)>(vb); r.h0 = tr_read<v_rd_off(D0, 0, 1)>(vb); r.l1 = tr_read<v_rd_off(D0, 1, 0)>(vb); r.h1 = tr_read<v_rd_off(D0, 1, 1)>(vb);
  r.l2 = tr_read<v_rd_off(D0, 2, 0)>(vb); r.h2 = tr_read<v_rd_off(D0, 2, 1)>(vb); r.l3 = tr_read<v_rd_off(D0, 3, 0)>(vb); r.h3 = tr_read<v_rd_off(D0, 3, 1)>(vb);
}
__device__ __forceinline__ void pv_mm(f32x16& od, const VB8& r, bf16x8 pa0, bf16x8 pa1, bf16x8 pa2, bf16x8 pa3) {
#define PK(L, H) (bf16x8){L[0], L[1], L[2], L[3], H[0], H[1], H[2], H[3]}
  od = __builtin_amdgcn_mfma_f32_32x32x16_bf16(pa0, PK(r.l0, r.h0), od, 0, 0, 0);
  od = __builtin_amdgcn_mfma_f32_32x32x16_bf16(pa1, PK(r.l1, r.h1), od, 0, 0, 0);
  od = __builtin_amdgcn_mfma_f32_32x32x16_bf16(pa2, PK(r.l2, r.h2), od, 0, 0, 0);
  od = __builtin_amdgcn_mfma_f32_32x32x16_bf16(pa3, PK(r.l3, r.h3), od, 0, 0, 0);
#undef PK
}
__device__ __forceinline__ void pv_d0(f32x16* o, int vb, bf16x8 pa0, bf16x8 pa1, bf16x8 pa2, bf16x8 pa3) {
  VB8 a, b;
  pv_rd<0>(a, vb); pv_rd<1>(b, vb);
  asm volatile("s_waitcnt lgkmcnt(8)" ::: "memory"); SBAR(); pv_mm(o[0], a, pa0, pa1, pa2, pa3); SBAR();
  pv_rd<2>(a, vb);
  asm volatile("s_waitcnt lgkmcnt(8)" ::: "memory"); SBAR(); pv_mm(o[1], b, pa0, pa1, pa2, pa3); SBAR();
  pv_rd<3>(b, vb);
  asm volatile("s_waitcnt lgkmcnt(8)" ::: "memory"); SBAR(); pv_mm(o[2], a, pa0, pa1, pa2, pa3); SBAR();
  asm volatile("s_waitcnt lgkmcnt(0)" ::: "memory"); SBAR(); pv_mm(o[3], b, pa0, pa1, pa2, pa3);
}

__device__ void attn_phase(const Params& p, int l, int L, unsigned char* smem, int T) {
  const int tid = otid(), wid = tid >> 6, lane = tid & 63, r32 = lane & 31, hi = lane >> 5;
  char* lds = (char*)smem;
  char* V_lds = lds; char* K_lds = lds + 3 * SHM_V;
  float* wsf = (float*)(lds + 3 * SHM_V + 2 * SHM_K) + wid * 128; float* li1 = wsf; float* al_l = wsf + 64;
  const bf16_t* QD = (const bf16_t*)(p.ws + OFF_QD); const bf16_t* KD = (const bf16_t*)(p.ws + OFF_KD); const bf16_t* VD = (const bf16_t*)(p.ws + OFF_VD);
  bf16_t* AB = (bf16_t*)(p.ws + OFF_AB);
  const float lam = ((const float*)(p.ws + OFF_LAM))[l], oml = ((const float*)(p.ws + OFF_LAM))[8 + l];
  const int nq = L / 256, NT = L / 64;
  const int vb0 = (int)(uintptr_t)V_lds + v_rd_base(lane);
  const int wid_u = __builtin_amdgcn_readfirstlane(wid);
  LAS unsigned char* ldsV = (LAS unsigned char*)smem; LAS unsigned char* ldsK = ldsV + 3 * SHM_V;
  const int half = wid_u >> 2;
  unsigned kso[2], vso[2];
#pragma unroll
  for (int i = 0; i < 2; ++i) { const int b = i * 8192 + tid * 16;
    { const int row = b >> 8, cphys = b & 255, colB = cphys ^ ((row & 7) << 4); kso[i] = (unsigned)(row * 1024 + colB); }
    { const int sub = b >> 9, kkhi = sub >> 2, chi = sub & 3, within = b & 511, kklo = within >> 6, clo = (within & 63) >> 1;
      const int kk = kkhi * 8 + kklo, k = (kk & ~0xC) | ((kk & 4) << 1) | ((kk & 8) >> 1); vso[i] = (unsigned)(k * 1024 + (chi * 32 + clo) * 2); } }
  const int nitems = (T / 256) * 4;
  for (int it = blockIdx.x; it < nitems; it += gridDim.x) {
    const int pair = (it & 7) * 4 + (it >> 3) / nq, qb = (it >> 3) % nq;
    const int s = pair >> 2, h = pair & 3;
    const size_t rowbase = (size_t)s * L;
    const bf16_t* Qb = QD + (rowbase + (size_t)qb * 256) * 512 + h * 128;
    const bf16_t* Kh = KD + rowbase * 512 + h * 128; const bf16_t* Vh = VD + rowbase * 512 + h * 128;
#pragma unroll 1
    for (int mp = 0; mp < 2; ++mp) {
      float m_reg = -1e30f, l_reg = 0.f;
      f32x16 o[4];
#pragma unroll
      for (int dd = 0; dd < 4; ++dd)
#pragma unroll
        for (int r = 0; r < 16; ++r) o[dd][r] = 0.f;
      bf16x8 qr[4];
      { const int t2 = otid(); const unsigned qoff = (unsigned)(((t2 >> 6) * 32 + (t2 & 31)) * 512 + ((t2 >> 5) & 1) * 8 + mp * 64) * 2u;
#pragma unroll
        for (int d0 = 0; d0 < 4; ++d0) qr[d0] = *(const bf16x8*)((const char*)Qb + qoff + d0 * 32); }
#define SDMA(k0, kb, vb) do { const char* kb_ = (const char*)Kh + (size_t)(k0) * 1024; const char* vb_ = (const char*)Vh + (size_t)(k0) * 1024; \
    _Pragma("unroll") for (int i_ = 0; i_ < 2; ++i_) { \
      __builtin_amdgcn_global_load_lds((const unsigned*)(kb_ + kso[i_]), (LAS unsigned*)(ldsK + (kb) * SHM_K + i_ * 8192 + wid_u * 1024), 16, 0, 0); \
      __builtin_amdgcn_global_load_lds((const unsigned*)(vb_ + vso[i_]), (LAS unsigned*)(ldsV + (vb) * SHM_V + i_ * 8192 + wid_u * 1024), 16, 0, 0); } } while (0)
      SDMA(0, 0, 0); asm volatile("s_waitcnt vmcnt(0)" ::: "memory"); __syncthreads();
      bf16x8 pa0, pa1, pa2, pa3;
      int vcur = 0, vprev = 2;
      for (int j = 0; j < NT; ++j) {
        const int cur = j & 1; const int vnext = vcur == 2 ? 0 : vcur + 1;
        if (j + 1 < NT) SDMA((j + 1) * 64, cur ^ 1, vnext);
        if (half == 1 && j > 0) pv_d0(o, vb0 + vprev * SHM_V, pa0, pa1, pa2, pa3);
        f32x16 p0, p1; float mn, al;
        qkt_half<0>(p0, p1, K_lds + cur * SHM_K + mp * 128, qr, r32, hi);
        partialSM(p0, p1, m_reg, mn, al);
        if (__any(al < 1.f)) { if (hi == 0) al_l[r32] = al; asm volatile("s_waitcnt lgkmcnt(0)" ::: "memory");
#pragma unroll
          for (int r = 0; r < 16; ++r) { const float av = al_l[crow(r, hi)];
#pragma unroll
            for (int dd = 0; dd < 4; ++dd) o[dd][r] *= av; } }
        finishSM(p0, p1, al, l_reg, pa0, pa1, pa2, pa3);
        if (half == 0) pv_d0(o, vb0 + vcur * SHM_V, pa0, pa1, pa2, pa3);
        asm volatile("s_waitcnt vmcnt(0)" ::: "memory");
        __syncthreads();
        vprev = vcur; vcur = vnext;
      }
      if (half == 1) pv_d0(o, vb0 + vprev * SHM_V, pa0, pa1, pa2, pa3);
      __syncthreads();
#undef SDMA
      if (hi == 0) li1[r32] = l_reg;
      asm volatile("s_waitcnt lgkmcnt(0)" ::: "memory");
      const int t3 = otid();
      f32x4* OS = (f32x4*)(p.ws + OFF_OS + (size_t)obid() * (512 * 256)) + (unsigned)t3;
      if (mp == 0) {
#pragma unroll
        for (int r4 = 0; r4 < 4; ++r4) { float il[4];
#pragma unroll
          for (int q = 0; q < 4; ++q) il[q] = __builtin_amdgcn_rcpf(li1[crow(r4 * 4 + q, hi)]);
#pragma unroll
          for (int dd = 0; dd < 4; ++dd) OS[(dd * 4 + r4) * 512] = (f32x4){o[dd][r4 * 4] * il[0], o[dd][r4 * 4 + 1] * il[1], o[dd][r4 * 4 + 2] * il[2], o[dd][r4 * 4 + 3] * il[3]}; }
      } else {
        const float* sw = p.subln + l * 128;
        const float sw0 = sw[r32], sw1 = sw[32 + r32], sw2 = sw[64 + r32], sw3 = sw[96 + r32];
        bf16_t* Ow = AB + (rowbase + (size_t)qb * 256) * 1024 + 512 + h * 128 + (unsigned)((t3 >> 6) * 32 * 1024 + (t3 & 31));
#pragma unroll
        for (int r4 = 0; r4 < 4; ++r4) { const f32x4 a0 = OS[r4 * 512], a1 = OS[(4 + r4) * 512], a2 = OS[(8 + r4) * 512], a3 = OS[(12 + r4) * 512];
#pragma unroll
          for (int q = 0; q < 4; ++q) { const int r = r4 * 4 + q; const int orow = crow(r, hi);
            const float i2 = lam * __builtin_amdgcn_rcpf(li1[orow]);
            const float v0 = a0[q] - o[0][r] * i2, v1 = a1[q] - o[1][r] * i2, v2 = a2[q] - o[2][r] * i2, v3 = a3[q] - o[3][r] * i2;
            float ss = v0 * v0 + v1 * v1 + v2 * v2 + v3 * v3;
            ss += __shfl_xor(ss, 1, 64); ss += __shfl_xor(ss, 2, 64); ss += __shfl_xor(ss, 4, 64); ss += __shfl_xor(ss, 8, 64); ss += __shfl_xor(ss, 16, 64);
            const float rs = rsqrtf(ss * (1.f / 128.f) + EPS) * oml;
            bf16_t* op = Ow + (size_t)orow * 1024;
            op[0] = f2bf(v0 * rs * sw0); op[32] = f2bf(v1 * rs * sw1); op[64] = f2bf(v2 * rs * sw2); op[96] = f2bf(v3 * rs * sw3); } }
      }
    }
  }
}

__device__ void init_sb(const Params& p, int sb) {
  const int T = sb == 0 ? 16384 : 32768, rowoff = sb == 0 ? 0 : 16384 + (sb - 1) * 32768;
  const float* xin = sb == 0 ? p.x_prompt : p.x_sample + (size_t)(sb - 1) * 32768 * 1024;
  rowwise_phase(xin, p.out + (size_t)rowoff * 1024, nullptr, nullptr, p.n_mix_pre, true, (bf16_t*)(p.ws + OFF_H), 1024, 0, nullptr, T, false);
}
__device__ __forceinline__ void run_step(const Params& p, int step, unsigned char* smem) {
  if (step == 0) { prep_phase(p, smem); init_sb(p, 0); return; }
  const int s_ = step - 1, sb = s_ / SPB, r = s_ % SPB;
  const int T = sb == 0 ? 16384 : 32768, rowoff = sb == 0 ? 0 : 16384 + (sb - 1) * 32768;
  const int L = sb == 0 ? 2048 : 4096, nseq = T / L, nc = L / 64;
  float* xres = p.out + (size_t)rowoff * 1024;
  unsigned char* ws = p.ws;
  const int l = r / PPL, seq_ = r % PPL;
  const int ph = seq_;
  unsigned char* wl = ws + (size_t)l * SZ_WL;
  LAS unsigned char* lds = (LAS unsigned char*)smem;
  pg8::StaticOrder S;
  switch (ph) {
    case 0: { pg8::Gemm g{(const bf16_t*)(ws + OFF_H), (const bf16_t*)(wl + OFF_WIN), 1024, 1024, T, INC, 1024};
      S.init(g.M, g.N, (int)gridDim.x, (int)blockIdx.x); EpiWin E{ws, l, L - 1}; pg8::gemm_phase<EpiWin, false>(lds, g, S, E, -1); } break;
    case 1: attn_phase(p, l, L, smem, T); __syncthreads(); hg_delta_phase(p, smem, T); break;
    case 2: hg_scan_phase(p, nseq, nc); break;
    case 3: hg_out_phase(p, l, smem, T); break;
    case 4: {
      pg8::Gemm g{(const bf16_t*)(ws + OFF_AB), (const bf16_t*)(wl + OFF_WAB), 1024, 1024, T, 1024, 1024};
      S.init(g.M, g.N, (int)gridDim.x, (int)blockIdx.x);
      EpiMerge E{(const bf16_t*)(ws + OFF_GA), (const bf16_t*)(ws + OFF_GB), (bf16_t*)(ws + OFF_M)};
      pg8::gemm_phase<EpiMerge, true>(lds, g, S, E, 8); } break;
    case 5: case 7: case 9: {
      pg8::Gemm g; EpiPlain E;
      if (ph == 5) { g = pg8::Gemm{(const bf16_t*)(ws + OFF_M), (const bf16_t*)(wl + OFF_WOUT), 1024, 1024, T, 1024, 1024}; E = EpiPlain{(bf16_t*)(ws + OFF_MO), 1024}; }
      else if (ph == 7) { g = pg8::Gemm{(const bf16_t*)(ws + OFF_H), (const bf16_t*)(wl + OFF_WUP), 1024, 1024, T, FF2, 1024}; E = EpiPlain{(bf16_t*)(ws + OFF_U), FF2}; }
      else { g = pg8::Gemm{(const bf16_t*)(ws + OFF_ACT), (const bf16_t*)(wl + OFF_WDOWN), FF, FF, T, 1024, FF}; E = EpiPlain{(bf16_t*)(ws + OFF_MO), 1024}; }
      S.init(g.M, g.N, (int)gridDim.x, (int)blockIdx.x); pg8::gemm_phase<EpiPlain, false>(lds, g, S, E, -1); } break;
    case 6: rowwise_phase(nullptr, xres, (const bf16_t*)(ws + OFF_MO), p.n_mix_post + l * 1024, p.n_ffn_pre + l * 1024, true, (bf16_t*)(ws + OFF_H), 1024, 0, nullptr, T, false); break;
    case 8: conv_phase((const bf16_t*)(ws + OFF_U), p.conv_w + (size_t)l * 3 * FF2, p.conv_b + (size_t)l * FF2, (bf16_t*)(ws + OFF_ACT), L - 1, T); break;
    case 10: { const float* pp = sb == 0 ? p.p_prompt + (size_t)l * 16384 * 256 : p.p_sample + ((size_t)l * 65536 + (size_t)(sb - 1) * 32768) * 256;
      rowwise_phase(nullptr, xres, (const bf16_t*)(ws + OFF_MO), p.n_ffn_post + l * 1024, nullptr, true, (bf16_t*)(ws + OFF_AP), 1280, 256, pp, T, false); } break;
    case 11: { pg8::Gemm g{(const bf16_t*)(ws + OFF_AP), (const bf16_t*)(wl + OFF_WPG), 1280, 1280, T, 1024, 1280};
      S.init(g.M, g.N, (int)gridDim.x, (int)blockIdx.x); EpiPle E{(bf16_t*)(ws + OFF_M)}; pg8::gemm_phase<EpiPle, true>(lds, g, S, E, 4); } break;
    case 12: rowwise_phase(nullptr, xres, (const bf16_t*)(ws + OFF_M), p.n_ple + l * 1024, l < 3 ? p.n_mix_pre + (l + 1) * 1024 : nullptr, l < 3, (bf16_t*)(ws + OFF_H), 1024, 0, nullptr, T, l == 3); if (l == NL - 1 && sb + 1 < NSB) init_sb(p, sb + 1); break;
    default: break;
  }
}


#define XB_TMO      128
#define XB_XCNT(j)  (256  + 64 * (j))
#define XB_XSUB(j)  (1280 + 64 * (j))
#define XB_XGEN(j)  (2304 + 64 * (j))
#define XB_TOP      3328
#define XB_TOPGEN   3392
#define XCD_BAR_WORDS 3456
#define XB_SPIN_CAP (1u << 18)
__device__ __forceinline__ unsigned xb_ld(unsigned* p)              { return __hip_atomic_load(p, __ATOMIC_RELAXED, __HIP_MEMORY_SCOPE_AGENT); }
__device__ __forceinline__ unsigned xb_add(unsigned* p, unsigned v) { return __hip_atomic_fetch_add(p, v, __ATOMIC_RELAXED, __HIP_MEMORY_SCOPE_AGENT); }
__device__ __forceinline__ unsigned xb_xcc_id() { return (unsigned)__builtin_amdgcn_s_getreg((3 << 11) | 20) & 0xFu; }
#define XB_SPIN(cond, bar) do { unsigned _sp = 0; while (cond) { __builtin_amdgcn_s_sleep(1); \
    if ((++_sp & 255u) == 0u) { if (xb_ld(&(bar)[XB_TMO])) break; if (_sp > XB_SPIN_CAP) { atomicAdd(&(bar)[XB_TMO], 1u); break; } } } } while (0)
__device__ __forceinline__ void xcd_barrier_complete(unsigned* bar, unsigned x, unsigned& nloc, unsigned& nx) {
  const unsigned G = gridDim.x * gridDim.y * gridDim.z;
  unsigned sum, cnt, mine, sp = 0u;
  for (;;) {
    sum = 0u; cnt = 0u; mine = 0u;
#pragma unroll
    for (unsigned j = 0; j < 16; ++j) { const unsigned c = xb_ld(&bar[XB_XCNT(j)]); sum += c; cnt += (c > 0u) ? 1u : 0u; mine = (j == x) ? c : mine; }
    if (sum == G) break;
    __builtin_amdgcn_s_sleep(1);
    if ((++sp & 255u) == 0u) { if (xb_ld(&bar[XB_TMO])) break; if (sp > XB_SPIN_CAP) { atomicAdd(&bar[XB_TMO], 1u); break; } }
  }
  nloc = mine > 0u ? mine : 1u; nx = cnt > 0u ? cnt : 1u;
}
__device__ __forceinline__ void xcd_barrier(unsigned* bar, volatile LAS unsigned* st) {
  asm volatile("s_waitcnt vmcnt(0)" ::: "memory");
  __syncthreads();
  if (threadIdx.x == 0) {
    const unsigned x = xb_xcc_id();
    __builtin_amdgcn_s_waitcnt(0);
    unsigned nloc = st[0], nx = st[1];
    if (nloc == 0u) { xcd_barrier_complete(bar, x, nloc, nx); st[0] = nloc; st[1] = nx; }
    const unsigned old = xb_add(&bar[XB_XSUB(x)], 1u);
    const unsigned gen = old / nloc;
    if (old + 1u == (gen + 1u) * nloc) {
      __builtin_amdgcn_fence(__ATOMIC_RELEASE, "agent");
      asm volatile("s_waitcnt vmcnt(0)" ::: "memory");
      const unsigned og = xb_add(&bar[XB_TOP], 1u);
      const unsigned tg = og / nx;
      if (og + 1u == (tg + 1u) * nx) xb_add(&bar[XB_TOPGEN], 1u);
      else XB_SPIN(xb_ld(&bar[XB_TOPGEN]) == tg, bar);
      __builtin_amdgcn_fence(__ATOMIC_ACQUIRE, "agent");
      xb_add(&bar[XB_XGEN(x)], 1u);
      asm volatile("s_waitcnt vmcnt(0)" ::: "memory");
    } else {
      XB_SPIN(xb_ld(&bar[XB_XGEN(x)]) == gen, bar);
      __builtin_amdgcn_fence(__ATOMIC_ACQUIRE, "agent");
      asm volatile("s_waitcnt vmcnt(0)" ::: "memory");
    }
  }
  __syncthreads();
}

__global__ __launch_bounds__(512, 2) void mega(Params p, int s_begin, int s_end) {
  extern __shared__ __attribute__((aligned(16))) unsigned char smem[];
#if ONE_LAUNCH
  cg::grid_group grid = cg::this_grid();
  volatile LAS unsigned* st = (volatile LAS unsigned*)((LAS unsigned char*)smem + 131072);
  unsigned* bar = (unsigned*)(p.ws + OFF_BAR);
  if (threadIdx.x == 0) { st[0] = 0u; st[1] = 0u; st[2] = 0u; st[3] = 0u; (void)xb_add(&bar[XB_XCNT(xb_xcc_id())], 1u); }
  __syncthreads();
#endif
  for (int step = s_begin; step < s_end; ++step) {
    run_step(p, step, smem);
#if ONE_LAUNCH
    if (step + 1 < s_end) { if (s_end < 0) grid.sync();
      xcd_barrier(bar, st); }
#endif
  }
}

extern "C" void kernel_launch(void* const* d_in, const int* in_sizes, int n_in, void* d_out, int out_size, void* d_ws, size_t ws_size, hipStream_t stream) {
  static int grid = 0;
  if (grid == 0) {
    if (n_in != 23 || ws_size < WS_END || out_size != NTOK * 1024) {
      fprintf(stderr, "kernel_launch: unexpected shapes: n_in %d out %d ws %zu (need %zu)\n", n_in, out_size, ws_size, (size_t)WS_END); grid = -1; return; }
    int dev = 0, cus = 0, per_cu = 0;
    hipGetDevice(&dev); hipDeviceGetAttribute(&cus, hipDeviceAttributeMultiprocessorCount, dev);
    if (hipFuncSetAttribute((const void*)mega, hipFuncAttributeMaxDynamicSharedMemorySize, LDS_BYTES) != hipSuccess) { fprintf(stderr, "kernel_launch: hipFuncSetAttribute failed\n"); grid = -1; return; }
    if (hipOccupancyMaxActiveBlocksPerMultiprocessor(&per_cu, (const void*)mega, 512, LDS_BYTES) != hipSuccess || per_cu < 1) { fprintf(stderr, "kernel_launch: occupancy query gave %d\n", per_cu); per_cu = 1; }
    (void)hipGetLastError();
    grid = cus * per_cu; if (grid > 256) grid = 256;
  }
  if (grid < 0) return;
  Params p{};
  p.x_prompt = (const float*)d_in[0]; p.x_sample = (const float*)d_in[1]; p.p_prompt = (const float*)d_in[2]; p.p_sample = (const float*)d_in[3];
  p.w_in = (const float*)d_in[4]; p.lb_logits = (const float*)d_in[5]; p.gnorm = (const float*)d_in[6]; p.dlam = (const float*)d_in[7]; p.subln = (const float*)d_in[8];
  p.w_a = (const float*)d_in[9]; p.w_b = (const float*)d_in[10]; p.w_out = (const float*)d_in[11]; p.n_mix_pre = (const float*)d_in[12]; p.n_mix_post = (const float*)d_in[13];
  p.w_up = (const float*)d_in[14]; p.conv_w = (const float*)d_in[15]; p.conv_b = (const float*)d_in[16]; p.w_down = (const float*)d_in[17]; p.n_ffn_pre = (const float*)d_in[18]; p.n_ffn_post = (const float*)d_in[19];
  p.w_ple = (const float*)d_in[20]; p.w_pg = (const float*)d_in[21]; p.n_ple = (const float*)d_in[22];
  p.out = (float*)d_out; p.ws = (unsigned char*)d_ws;
#if ONE_LAUNCH
  if (hipMemsetAsync((char*)d_ws + OFF_BAR, 0, XCD_BAR_WORDS * 4, stream) != hipSuccess) { fprintf(stderr, "kernel_launch: memset of barrier words failed\n"); return; }
  int s0 = 0, s1 = NSTEPS;
  void* args[] = {&p, &s0, &s1};
  hipError_t e = hipLaunchCooperativeKernel((const void*)mega, dim3(grid), dim3(512), args, LDS_BYTES, stream);
  if (e != hipSuccess) fprintf(stderr, "cooperative launch failed: %s (grid %d)\n", hipGetErrorString(e), grid);
#else
  for (int s = 0; s < NSTEPS; ++s) hipLaunchKernelGGL(mega, dim3(grid), dim3(512), LDS_BYTES, stream, p, s, s + 1);
#endif
}
```
